# Optimizing an MI355X kernel written in HIP

```python
import math
import jax, jax.numpy as jnp
from jax import lax
import numpy as np

D_MODEL = 2048
BATCH = 4
SEQ = 2048
DEPTH = 1

CHUNK = 64
N_META = 16
Q_BLOCK = 128
ATT_HEADS = 8
ATT_QK_DIM = 64
ATT_V_DIM = 128
DN_HEADS = 8
DN_K_DIM = 128
DN_V_DIM = 128
DN_CONV = 4
D_FF = 5632
FFN_CONV = 3
ROPE_THETA = 10000.0
LN_EPS = 1e-5
RMS_EPS = 1e-6

ATT_QK_W = ATT_HEADS * 2 * ATT_QK_DIM
ATT_V_W = ATT_HEADS * ATT_V_DIM
DN_QK_W = DN_HEADS * DN_K_DIM
DN_V_W = DN_HEADS * DN_V_DIM
MIX_WIDTH = ATT_V_W + DN_V_W
SPLITS = (ATT_QK_W, ATT_QK_W, ATT_V_W, DN_QK_W, DN_QK_W, DN_V_W, DN_V_W, DN_HEADS, DN_HEADS)
IN_COLS = 3 * 1024 + 4 * 1024 + 2 * DN_HEADS

kernel_name = "hybrid_diffattn_gdn_convffn_deepnorm"


def layer_norm(x, g, b):
    xf = x.astype(jnp.float32)
    mu = jnp.mean(xf, axis=-1, keepdims=True)
    var = jnp.mean(jnp.square(xf - mu), axis=-1, keepdims=True)
    return ((xf - mu) * lax.rsqrt(var + LN_EPS) * g.astype(jnp.float32) + b.astype(jnp.float32)).astype(x.dtype)


def rms_norm(x, w):
    xf = x.astype(jnp.float32)
    return (xf * lax.rsqrt(jnp.mean(jnp.square(xf), axis=-1, keepdims=True) + RMS_EPS) * w.astype(jnp.float32)).astype(x.dtype)


def l2_normalize(x):
    return x * lax.rsqrt(jnp.sum(jnp.square(x), axis=-1, keepdims=True) + RMS_EPS)


def causal_dwconv(x, w):
    k_w = w.shape[0]
    n = x.shape[1]
    xp = jnp.pad(x, ((0, 0), (k_w - 1, 0), (0, 0)))
    y = xp[:, 0:n] * w[0]
    for j in range(1, k_w):
        y = y + xp[:, j:j + n] * w[j]
    return y


def rope(x, pos):
    d = x.shape[-1]
    inv_freq = ROPE_THETA ** (-jnp.arange(0, d, 2, dtype=jnp.float32) / d)
    ang = pos[:, None] * inv_freq[None, :]
    cos = jnp.cos(ang)[None, :, None, None, :]
    sin = jnp.sin(ang)[None, :, None, None, :]
    xf = x.astype(jnp.float32)
    x1, x2 = xf[..., : d // 2], xf[..., d // 2:]
    return jnp.concatenate([x1 * cos - x2 * sin, x2 * cos + x1 * sin], axis=-1)


def diff_attention(q, k, v, lam, lam_init, norm_w, cid):
    b_, n, h, _, dq = q.shape
    scale = dq ** -0.5
    n_real = n - N_META
    bounds = [(0, N_META)] + [(N_META + i * Q_BLOCK, N_META + (i + 1) * Q_BLOCK) for i in range(n_real // Q_BLOCK)]
    vf = v.astype(jnp.float32)
    outs = []
    for s, e in bounds:
        scores = jnp.einsum('bqhcd,bkhcd->bhcqk', q[:, s:e], k[:, :e]) * scale
        mask = cid[None, :e] <= cid[s:e, None]
        p = jax.nn.softmax(jnp.where(mask, scores, -jnp.inf), axis=-1)
        a = p[:, :, 0] - lam * p[:, :, 1]
        outs.append(jnp.einsum('bhqk,bkhe->bqhe', a, vf[:, :e]))
    o = jnp.concatenate(outs, axis=1)
    o = rms_norm(o, norm_w) * (1.0 - lam_init)
    return o.reshape(b_, n, h * o.shape[-1])


def gated_delta_rule(q, k, v, beta, g):
    b_, n, h, dk = q.shape
    dv = v.shape[-1]
    pad = (-n) % CHUNK
    n_p = n + pad
    nc = n_p // CHUNK

    def front_pad(t):
        return jnp.pad(t, ((0, 0), (pad, 0)) + ((0, 0),) * (t.ndim - 2))

    def to_chunks(t):
        t = jnp.swapaxes(front_pad(t), 1, 2)
        return t.reshape(t.shape[:2] + (nc, CHUNK) + t.shape[3:])

    q, k, v, beta, g = (to_chunks(t) for t in (q, k, v, beta, g))
    gc = jnp.cumsum(g, axis=-1)
    idx = jnp.arange(CHUNK)
    tril = idx[:, None] >= idx[None, :]
    strict = idx[:, None] > idx[None, :]
    decay = jnp.exp(jnp.where(tril, gc[..., :, None] - gc[..., None, :], -jnp.inf))
    kb = k * beta[..., None]
    vb = v * beta[..., None]
    m = jnp.where(strict, jnp.einsum('bhncd,bhnsd->bhncs', kb, k) * decay, 0.0)
    eye = jnp.eye(CHUNK, dtype=jnp.float32)
    rhs = jnp.concatenate([vb, kb * jnp.exp(gc)[..., None]], axis=-1)
    sol = lax.linalg.triangular_solve(eye + m, rhs, left_side=True, lower=True)
    u, w = sol[..., :dv], sol[..., dv:]
    qk = jnp.einsum('bhncd,bhnsd->bhncs', q, k) * decay
    q_dec = q * jnp.exp(gc)[..., None]
    k_dec = k * jnp.exp(gc[..., -1:] - gc)[..., None]
    g_last = jnp.exp(gc[..., -1])
    xs = tuple(jnp.moveaxis(t, 2, 0) for t in (u, w, qk, q_dec, k_dec, g_last))

    def step(state, inp):
        u_c, w_c, qk_c, qd_c, kd_c, gl_c = inp
        v_new = u_c - jnp.einsum('bhck,bhkv->bhcv', w_c, state)
        o_c = jnp.einsum('bhck,bhkv->bhcv', qd_c, state) + jnp.einsum('bhcs,bhsv->bhcv', qk_c, v_new)
        state = state * gl_c[..., None, None] + jnp.einsum('bhck,bhcv->bhkv', kd_c, v_new)
        return state, o_c

    s0 = jnp.zeros((b_, h, dk, dv), jnp.float32)
    _, o = lax.scan(step, s0, xs)
    o = o.transpose(1, 0, 3, 2, 4).reshape(b_, n_p, h, dv)
    return o[:, pad:]


def hybrid_mixer(x, w_in, conv_w, a_log, dt_bias, lq1, lk1, lq2, lk2, diff_norm_w, delta_norm_w, w_out, layer_idx, cid, pos):
    b_, n, _ = x.shape
    points, acc = [], 0
    for s in SPLITS[:-1]:
        acc += s
        points.append(acc)
    aq, ak, av, dq, dk, dv, dz, db, da = jnp.split(x @ w_in, points, axis=-1)

    aq = rope(aq.reshape(b_, n, ATT_HEADS, 2, ATT_QK_DIM), pos)
    ak = rope(ak.reshape(b_, n, ATT_HEADS, 2, ATT_QK_DIM), pos)
    av = av.reshape(b_, n, ATT_HEADS, ATT_V_DIM)
    lam_init = 0.8 - 0.6 * math.exp(-0.3 * layer_idx)
    f32 = jnp.float32
    lam = (jnp.exp(jnp.sum(lq1.astype(f32) * lk1.astype(f32))) - jnp.exp(jnp.sum(lq2.astype(f32) * lk2.astype(f32))) + lam_init)
    o_att = diff_attention(aq, ak, av, lam, lam_init, diff_norm_w, cid)

    qkv = jax.nn.silu(causal_dwconv(jnp.concatenate([dq, dk, dv], axis=-1), conv_w)).astype(f32)
    dq, dk, dv = jnp.split(qkv, [DN_QK_W, 2 * DN_QK_W], axis=-1)
    dq = l2_normalize(dq.reshape(b_, n, DN_HEADS, DN_K_DIM)) * (DN_K_DIM ** -0.5)
    dk = l2_normalize(dk.reshape(b_, n, DN_HEADS, DN_K_DIM))
    dv = dv.reshape(b_, n, DN_HEADS, DN_V_DIM)
    beta = jax.nn.sigmoid(db.astype(f32))
    g = -jnp.exp(a_log.astype(f32)) * jax.nn.softplus(da.astype(f32) + dt_bias.astype(f32))
    o_dn = gated_delta_rule(dq, dk, dv, beta, g)
    o_dn = rms_norm(o_dn, delta_norm_w) * jax.nn.silu(dz.reshape(b_, n, DN_HEADS, DN_V_DIM).astype(f32))
    o_dn = o_dn.reshape(b_, n, DN_V_W)

    o = jnp.concatenate([o_att, o_dn], axis=-1).astype(x.dtype)
    return o @ w_out


def conv_ffn(x, w_gate, w_up, conv_w, conv_b, w_down):
    h = causal_dwconv(x @ w_gate, conv_w) + conv_b
    return (jax.nn.silu(h) * (x @ w_up)) @ w_down


def setup_inputs(seed: int = 0) -> dict:
    key = jax.random.key(seed)
    ks = jax.random.split(key, 24)
    beta_dn = (8.0 * DEPTH) ** -0.25
    nrm = jax.random.normal
    dt = jnp.exp(jax.random.uniform(ks[4], (DEPTH, DN_HEADS)) * (math.log(0.1) - math.log(0.001)) + math.log(0.001))
    return {
        "x": nrm(ks[0], (BATCH, SEQ, D_MODEL), jnp.float32),
        "meta_tokens": nrm(ks[1], (N_META, D_MODEL), jnp.float32),
        "w_in": nrm(ks[2], (DEPTH, D_MODEL, IN_COLS), jnp.float32) * D_MODEL ** -0.5,
        "conv_qkv_w": nrm(ks[3], (DEPTH, DN_CONV, 2 * DN_QK_W + DN_V_W), jnp.float32) * DN_CONV ** -0.5,
        "a_log": jnp.log(jax.random.uniform(ks[5], (DEPTH, DN_HEADS), minval=1.0, maxval=16.0)),
        "dt_bias": dt + jnp.log(-jnp.expm1(-dt)),
        "lambda_q1": nrm(ks[6], (DEPTH, ATT_QK_DIM), jnp.float32) * 0.1,
        "lambda_k1": nrm(ks[7], (DEPTH, ATT_QK_DIM), jnp.float32) * 0.1,
        "lambda_q2": nrm(ks[8], (DEPTH, ATT_QK_DIM), jnp.float32) * 0.1,
        "lambda_k2": nrm(ks[9], (DEPTH, ATT_QK_DIM), jnp.float32) * 0.1,
        "diff_norm_w": 1.0 + 0.01 * nrm(ks[10], (DEPTH, ATT_V_DIM), jnp.float32),
        "delta_norm_w": 1.0 + 0.01 * nrm(ks[11], (DEPTH, DN_V_DIM), jnp.float32),
        "w_out": nrm(ks[12], (DEPTH, MIX_WIDTH, D_MODEL), jnp.float32) * MIX_WIDTH ** -0.5 * beta_dn,
        "ln1_g": 1.0 + 0.01 * nrm(ks[13], (DEPTH, D_MODEL), jnp.float32),
        "ln1_b": 0.01 * nrm(ks[14], (DEPTH, D_MODEL), jnp.float32),
        "ffn_w_gate": nrm(ks[15], (DEPTH, D_MODEL, D_FF), jnp.float32) * D_MODEL ** -0.5,
        "ffn_w_up": nrm(ks[16], (DEPTH, D_MODEL, D_FF), jnp.float32) * D_MODEL ** -0.5,
        "ffn_conv_w": nrm(ks[17], (DEPTH, FFN_CONV, D_FF), jnp.float32) * FFN_CONV ** -0.5,
        "ffn_conv_b": 0.01 * nrm(ks[18], (DEPTH, D_FF), jnp.float32),
        "ffn_w_down": nrm(ks[19], (DEPTH, D_FF, D_MODEL), jnp.float32) * D_FF ** -0.5 * beta_dn,
        "ln2_g": 1.0 + 0.01 * nrm(ks[20], (DEPTH, D_MODEL), jnp.float32),
        "ln2_b": 0.01 * nrm(ks[21], (DEPTH, D_MODEL), jnp.float32),
    }


def reference(x, meta_tokens, w_in, conv_qkv_w, a_log, dt_bias, lambda_q1, lambda_k1, lambda_q2, lambda_k2,
              diff_norm_w, delta_norm_w, w_out, ln1_g, ln1_b, ffn_w_gate, ffn_w_up, ffn_conv_w, ffn_conv_b,
              ffn_w_down, ln2_g, ln2_b):
    b_, n, d = x.shape
    meta = jnp.broadcast_to(meta_tokens[None].astype(x.dtype), (b_, N_META, d))
    h = jnp.concatenate([meta, x], axis=1)
    pos = jnp.arange(n + N_META, dtype=jnp.float32)
    cid = jnp.concatenate([jnp.full((N_META,), -1, jnp.int32), jnp.arange(n, dtype=jnp.int32) // CHUNK])
    alpha = (2.0 * DEPTH) ** 0.25
    for l in range(DEPTH):
        mix = hybrid_mixer(h, w_in[l], conv_qkv_w[l], a_log[l], dt_bias[l], lambda_q1[l], lambda_k1[l],
                           lambda_q2[l], lambda_k2[l], diff_norm_w[l], delta_norm_w[l], w_out[l], l, cid, pos)
        h = layer_norm(alpha * h + mix, ln1_g[l], ln1_b[l])
        ffn = conv_ffn(h, ffn_w_gate[l], ffn_w_up[l], ffn_conv_w[l], ffn_conv_b[l], ffn_w_down[l])
        h = layer_norm(alpha * h + ffn, ln2_g[l], ln2_b[l])
    return h[:, N_META:]
```

```cpp
#include <hip/hip_runtime.h>
#include <hip/hip_cooperative_groups.h>
#include <cstdio>
#define DBG_NANFIX 1
#define DBG_CLO 0
#define DBG_CHI 2048
namespace cg = cooperative_groups;

#define LAS __attribute__((address_space(3)))
typedef unsigned short bf16_t;
typedef short bf16x8 __attribute__((ext_vector_type(8)));
typedef short s16x4 __attribute__((ext_vector_type(4)));
typedef float f32x4 __attribute__((ext_vector_type(4)));
typedef float f32x2 __attribute__((ext_vector_type(2)));
typedef unsigned u32x4 __attribute__((ext_vector_type(4)));
typedef unsigned u32x2 __attribute__((ext_vector_type(2)));

constexpr int NB = 4, SEQ = 2048, NMETA = 16, LTOK = SEQ + NMETA, FPAD = 48, LPAD = LTOK + FPAD  , R = NB * LPAD  ;
constexpr int DM = 2048, NPROJ = 7168, INCOLS = 7184, DFF = 5632, NCH = LPAD / 64  ;
constexpr float ALPHA = 1.189207115002721f;
constexpr float LAM_INIT = 0.2f;
constexpr int NTHR = 512, NWAVE = 8;
constexpr int LDS_BYTES = 147456;

constexpr size_t MiB = 1u << 20;
constexpr size_t WS_BA = 0;
constexpr size_t WS_GL = 1 * MiB;
constexpr size_t WS_CNT = 2 * MiB;
constexpr size_t WS_P = 4 * MiB;
constexpr size_t WS_WINT = 120 * MiB;
constexpr size_t WS_H0 = 148 * MiB;
constexpr size_t WS_QR = 120 * MiB;
constexpr size_t WS_KR = WS_QR + (size_t)R * 1024 * 2;
constexpr size_t WS_PREP = 153 * MiB;
constexpr size_t PREP_ITEM = 73728;
constexpr size_t WS_WOUT = 228 * MiB;
constexpr size_t WS_PRE1 = 120 * MiB;
constexpr size_t WS_H1B = 4 * MiB;
constexpr size_t WS_G = 37 * MiB;
constexpr size_t WS_ACT = 128 * MiB;
constexpr size_t WS_WG = 219 * MiB;
constexpr size_t WS_WU = 241 * MiB;
constexpr size_t WS_END = 263 * MiB;
static_assert(WS_KR + (size_t)R * 1024 * 2 <= WS_PREP && WS_PREP + (size_t)NB * 8 * NCH * PREP_ITEM <= WS_WOUT, "ws map");
static_assert(WS_G + (size_t)R * DFF * 2 <= WS_ACT && WS_ACT + (size_t)R * DFF * 2 <= WS_WG, "ws map 2");

typedef __bf16 bf16x2v __attribute__((ext_vector_type(2)));
__device__ __forceinline__ unsigned cvt_pk_bf16(float lo, float hi) { const f32x2 v = {lo, hi}; const bf16x2v b = __builtin_convertvector(v, bf16x2v); return __builtin_bit_cast(unsigned, b); }
__device__ __forceinline__ float bf2f(unsigned short b) { return __uint_as_float(((unsigned)b) << 16); }
__device__ __forceinline__ float bflo(unsigned w) { return __uint_as_float(w << 16); }
__device__ __forceinline__ float bfhi(unsigned w) { return __uint_as_float(w & 0xffff0000u); }
__device__ __forceinline__ bf16_t f2bf(float f) { return (bf16_t)(cvt_pk_bf16(f, 0.f) & 0xffffu); }
__device__ __forceinline__ float wave_sum(float v) {
#pragma unroll
  for (int o = 1; o < 64; o <<= 1) v += __shfl_xor(v, o);
  return v;
}
__device__ __forceinline__ float siluf(float x) { return x / (1.f + __expf(-x)); }
#define LDS_WAIT() asm volatile("s_waitcnt lgkmcnt(0)" ::: "memory")

struct KArgs { const float* in[22]; float* out; unsigned char* ws; int ph_lo, ph_hi; };

namespace pg8 {
constexpr int BM = 256, BK = 64, HALF = 128, HTB = HALF * BK * 2, STAGE_BYTES = 8 * HTB, NXCD = 8, WGM = 8;
__host__ __device__ __forceinline__ int lds_byte(int r, int c) { const int st = (r >> 4) * 2 + (c >> 5), rr = r & 15, cc = c & 31, ob = rr * 64 + cc * 2; return st * 1024 + (ob ^ (((ob >> 9) & 1) << 5)); }
__host__ __device__ __forceinline__ void stage_rc(int b, int& Rr, int& C) { const int st = b / 1024, sb = b % 1024, swz = sb ^ (((sb >> 9) & 1) << 5); Rr = (st >> 1) * 16 + swz / 64; C = (st & 1) * 32 + (swz % 64) / 2; }
__host__ __device__ __forceinline__ int perm32(int rho) { const int n = rho >> 4, i = rho & 15; return 8 * (i >> 2) + 4 * n + (i & 3); }
struct Unit { int pm, pn; };
struct Gemm { const bf16_t* A; const bf16_t* Bt; int lda, K; int rowmap; };
__device__ __forceinline__ size_t a_row0(int rowmap, int pm) { return rowmap ? (size_t)((pm >> 3) * LPAD + 64 + (pm & 7) * 256) : (size_t)pm * 256; }
struct StaticOrder {
  int nM, nN, nwg, G, c;
  __device__ void init(int nM_, int nN_, int G_, int c_) { nM = nM_; nN = nN_; nwg = nM * nN; G = G_; c = c_; }
  __device__ bool next(int i, Unit& u) const {
    const long L = (long)i * G + c; if (L >= nwg) return false;
    int wgid = (int)L; { const int q = nwg / NXCD, r = nwg % NXCD, xcd = wgid % NXCD, off = wgid / NXCD; wgid = (xcd < r ? xcd * (q + 1) : r * (q + 1) + (xcd - r) * q) + off; }
    const int nig = WGM * nN, gid = wgid / nig, fm = gid * WGM, gsz = (nM - fm) < WGM ? (nM - fm) : WGM;
    u.pm = fm + ((wgid % nig) % gsz); u.pn = (wgid % nig) / gsz; return true;
  }
};

template <class Epi>
__device__ __forceinline__ void gemm_phase(LAS unsigned char* lds, const Gemm g, const StaticOrder& S, const Epi& E) {
  const int tid = threadIdx.x, wid = __builtin_amdgcn_readfirstlane(tid >> 6), lane = tid & 63, wr = wid >> 2, wc = wid & 3, fr = lane & 15, fq = lane >> 4;
  const int K = g.K, nt = K / BK, lda = g.lda;
  unsigned voffA[2], voffB[2];
#pragma unroll
  for (int i = 0; i < 2; ++i) { int Rr, C; stage_rc(tid * 16 + i * 8192, Rr, C); const int Rb = Epi::PERM ? ((Rr & ~31) + perm32(Rr & 31)) : Rr;
    voffA[i] = (unsigned)(Rr * lda + C) * 2u; voffB[i] = (unsigned)(Rb * K + C) * 2u; }
  const size_t kstep = (size_t)(BK * 2);
  const size_t hstepA = (size_t)HALF * lda * 2, hstepB = (size_t)HALF * K * 2;
  const unsigned ldsw = (unsigned)wid * 1024u;
  const int aoff = lds_byte(wr * 64 + fr, fq * 8), boff = lds_byte(wc * 32 + fr, fq * 8);
#define PG8_SA(b, h) (((b) * 2 + (h)) * HTB)
#define PG8_SB(b, h) ((4 + (b) * 2 + (h)) * HTB)
#define PG8_STAGE(bufoff, gbase, voff) do { _Pragma("unroll") for (int _i = 0; _i < 2; ++_i) \
    __builtin_amdgcn_global_load_lds((const unsigned*)((const char*)(gbase) + (voff)[_i]), (LAS unsigned*)(lds + (bufoff) + ldsw + _i * 8192), 16, 0, 0); } while (0)
#define PG8_LDA(dst, b, h) do { _Pragma("unroll") for (int m = 0; m < 4; ++m) _Pragma("unroll") for (int k = 0; k < 2; ++k) dst[m][k] = *(const LAS bf16x8*)(lds + PG8_SA(b, h) + aoff + m * 2048 + k * 1024); } while (0)
#define PG8_LDB(dst, b, h) do { _Pragma("unroll") for (int n = 0; n < 2; ++n) _Pragma("unroll") for (int k = 0; k < 2; ++k) dst[n][k] = *(const LAS bf16x8*)(lds + PG8_SB(b, h) + boff + n * 2048 + k * 1024); } while (0)
#define PG8_MMA(ai, bj, At, Bt) do { __builtin_amdgcn_s_setprio(1); _Pragma("unroll") for (int m = 0; m < 4; ++m) _Pragma("unroll") for (int n = 0; n < 2; ++n) _Pragma("unroll") for (int k = 0; k < 2; ++k) \
    acc[ai][bj][m][n] = __builtin_amdgcn_mfma_f32_16x16x32_bf16(Bt[n][k], At[m][k], acc[ai][bj][m][n], 0, 0, 0); __builtin_amdgcn_s_setprio(0); } while (0)
#define PG8_WAIT_V(n) asm volatile("s_waitcnt vmcnt(" #n ")" ::: "memory")
#define PG8_WAIT_L(n) asm volatile("s_waitcnt lgkmcnt(" #n ")" ::: "memory")
#define PG8_BAR __builtin_amdgcn_s_barrier()
#define PG8_SCHED __builtin_amdgcn_sched_barrier(0)
  Unit cur, nxt; int ui = 0;
  if (!S.next(0, cur)) return;
  f32x4 acc[2][2][4][2];
#pragma unroll
  for (int a = 0; a < 2; ++a)
#pragma unroll
    for (int b = 0; b < 2; ++b)
#pragma unroll
      for (int m = 0; m < 4; ++m)
#pragma unroll
        for (int n = 0; n < 2; ++n) acc[a][b][m][n] = (f32x4){0.f, 0.f, 0.f, 0.f};
  bf16x8 At[4][2], B0[2][2], B1[2][2];
  const char* cA = (const char*)g.A + a_row0(g.rowmap, cur.pm) * lda * 2; const char* cB = (const char*)g.Bt + (size_t)cur.pn * 2 * hstepB;
  PG8_STAGE(PG8_SB(0, 0), cB, voffB); PG8_STAGE(PG8_SA(0, 0), cA, voffA); PG8_STAGE(PG8_SB(0, 1), cB + hstepB, voffB); PG8_STAGE(PG8_SA(0, 1), cA + hstepA, voffA);
  if (wr == 1) PG8_BAR;
  PG8_WAIT_V(4); PG8_BAR;
  PG8_STAGE(PG8_SB(1, 0), cB + kstep, voffB); PG8_STAGE(PG8_SA(1, 0), cA + kstep, voffA); PG8_STAGE(PG8_SB(1, 1), cB + hstepB + kstep, voffB);
  PG8_WAIT_V(6); PG8_BAR;
  for (;;) {
    const bool has_next = S.next(ui + 1, nxt);
    const char* nA = has_next ? (const char*)g.A + a_row0(g.rowmap, nxt.pm) * lda * 2 : cA; const char* nB = has_next ? (const char*)g.Bt + (size_t)nxt.pn * 2 * hstepB : cB;
    for (int t = 0; t < nt; t += 2) {
      const bool last = (t == nt - 2);
      const char* a1 = cA + (size_t)(t + 1) * kstep;
      const char* a2 = last ? nA : cA + (size_t)(t + 2) * kstep; const char* b2 = last ? nB : cB + (size_t)(t + 2) * kstep;
      const char* a3 = a2 + kstep; const char* b3 = b2 + kstep;
      PG8_LDB(B0, 0, 0); PG8_SCHED; PG8_LDA(At, 0, 0); PG8_STAGE(PG8_SA(1, 1), a1 + hstepA, voffA);
      PG8_WAIT_L(8); PG8_BAR; PG8_WAIT_L(0); PG8_MMA(0, 0, At, B0); PG8_BAR; PG8_SCHED;
      PG8_LDB(B1, 0, 1); PG8_STAGE(PG8_SB(0, 0), b2, voffB);
      PG8_BAR; PG8_WAIT_L(0); PG8_MMA(0, 1, At, B1); PG8_BAR;
      PG8_LDA(At, 0, 1); PG8_STAGE(PG8_SA(0, 0), a2, voffA);
      PG8_BAR; PG8_WAIT_L(0); PG8_MMA(1, 0, At, B0); PG8_BAR; PG8_SCHED;
      PG8_STAGE(PG8_SB(0, 1), b2 + hstepB, voffB);
      PG8_WAIT_V(6); PG8_BAR; PG8_MMA(1, 1, At, B1); PG8_BAR;
      PG8_LDB(B0, 1, 0); PG8_SCHED; PG8_LDA(At, 1, 0); PG8_STAGE(PG8_SA(0, 1), a2 + hstepA, voffA);
      PG8_WAIT_L(8); PG8_BAR; PG8_WAIT_L(0); PG8_MMA(0, 0, At, B0); PG8_BAR; PG8_SCHED;
      PG8_LDB(B1, 1, 1); PG8_STAGE(PG8_SB(1, 0), b3, voffB);
      PG8_BAR; PG8_WAIT_L(0); PG8_MMA(0, 1, At, B1); PG8_BAR;
      PG8_LDA(At, 1, 1); PG8_STAGE(PG8_SA(1, 0), a3, voffA);
      PG8_BAR; PG8_WAIT_L(0); PG8_MMA(1, 0, At, B0); PG8_BAR; PG8_SCHED;
      PG8_STAGE(PG8_SB(1, 1), b3 + hstepB, voffB);
      PG8_WAIT_V(6); PG8_BAR; PG8_MMA(1, 1, At, B1); PG8_BAR;
    }
    E(acc, cur, wr, wc, fr, fq);
    if (!has_next) break;
#pragma unroll
    for (int a = 0; a < 2; ++a)
#pragma unroll
      for (int b = 0; b < 2; ++b)
#pragma unroll
        for (int m = 0; m < 4; ++m)
#pragma unroll
          for (int n = 0; n < 2; ++n) acc[a][b][m][n] = (f32x4){0.f, 0.f, 0.f, 0.f};
    cur = nxt; cA = nA; cB = nB; ++ui;
  }
  PG8_WAIT_V(0);
  if (wr == 0) PG8_BAR;
  PG8_BAR;
#undef PG8_SA
#undef PG8_SB
#undef PG8_STAGE
#undef PG8_LDA
#undef PG8_LDB
#undef PG8_MMA
#undef PG8_WAIT_V
#undef PG8_WAIT_L
#undef PG8_BAR
#undef PG8_SCHED
}

struct EpiBf16 {
  static constexpr bool PERM = true;
  bf16_t* O; int ldc;
  __device__ __forceinline__ void operator()(const f32x4 (&acc)[2][2][4][2], const Unit& u, int wr, int wc, int fr, int fq) const {
    const int row0 = u.pm * BM + wr * 64 + fr, col0 = u.pn * BM + wc * 32 + 8 * fq;
#pragma unroll
    for (int ai = 0; ai < 2; ++ai)
#pragma unroll
      for (int m = 0; m < 4; ++m) { bf16_t* rowp = O + (size_t)(row0 + ai * HALF + m * 16) * ldc + col0;
#pragma unroll
        for (int bj = 0; bj < 2; ++bj) { const f32x4 v0 = acc[ai][bj][m][0], v1 = acc[ai][bj][m][1];
          u32x4 w; w.x = cvt_pk_bf16(v0[0], v0[1]); w.y = cvt_pk_bf16(v0[2], v0[3]); w.z = cvt_pk_bf16(v1[0], v1[1]); w.w = cvt_pk_bf16(v1[2], v1[3]);
          *(u32x4*)(rowp + bj * HALF) = w; } }
  }
};
struct EpiOutProj {
  static constexpr bool PERM = false;
  float* C; const float* x; const float* meta;
  __device__ __forceinline__ void operator()(const f32x4 (&acc)[2][2][4][2], const Unit& u, int wr, int wc, int fr, int fq) const {
    const int row0 = u.pm * BM + wr * 64 + fr, col0 = u.pn * BM + wc * 32 + 4 * fq;
#pragma unroll
    for (int ai = 0; ai < 2; ++ai)
#pragma unroll
      for (int m = 0; m < 4; ++m) { const int r = row0 + ai * HALF + m * 16; const int b = r / LPAD, p = r - b * LPAD, t = p - FPAD;
        if (t < 0) continue;
        const float* src = (t < NMETA ? meta + (size_t)t * DM : x + ((size_t)b * SEQ + (t - NMETA)) * DM) + col0;
        float* rowp = C + (size_t)r * DM + col0;
#pragma unroll
        for (int bj = 0; bj < 2; ++bj)
#pragma unroll
          for (int n = 0; n < 2; ++n) { const f32x4 h = *(const f32x4*)(src + bj * HALF + n * 16); *(f32x4*)(rowp + bj * HALF + n * 16) = acc[ai][bj][m][n] + h * ALPHA; } }
  }
};
struct EpiUpAct {
  static constexpr bool PERM = true;
  bf16_t* O; const bf16_t* G; const float* cw; const float* cb;
  __device__ __forceinline__ void operator()(const f32x4 (&acc)[2][2][4][2], const Unit& u, int wr, int wc, int fr, int fq) const {
    const int row0 = u.pm * BM + wr * 64 + fr, col0 = u.pn * BM + wc * 32 + 8 * fq;
#pragma unroll
    for (int bj = 0; bj < 2; ++bj) { const int c = col0 + bj * HALF;
      float w0[8], w1[8], w2[8], bb[8];
#pragma unroll
      for (int j = 0; j < 8; ++j) { w0[j] = cw[c + j]; w1[j] = cw[DFF + c + j]; w2[j] = cw[2 * DFF + c + j]; bb[j] = cb[c + j]; }
#pragma unroll
      for (int ai = 0; ai < 2; ++ai)
#pragma unroll
        for (int m = 0; m < 4; ++m) { const int r = row0 + ai * HALF + m * 16; const int r1 = r > 0 ? r - 1 : 0, r2 = r > 1 ? r - 2 : 0;
          const u32x4 g0 = *(const u32x4*)(G + (size_t)r * DFF + c), g1 = *(const u32x4*)(G + (size_t)r1 * DFF + c), g2 = *(const u32x4*)(G + (size_t)r2 * DFF + c);
          const f32x4 v0 = acc[ai][bj][m][0], v1 = acc[ai][bj][m][1];
          float up[8] = {v0[0], v0[1], v0[2], v0[3], v1[0], v1[1], v1[2], v1[3]}, o[8];
#pragma unroll
          for (int j = 0; j < 8; ++j) { const unsigned a0 = g0[j >> 1], a1 = g1[j >> 1], a2 = g2[j >> 1];
            const float x0 = (j & 1) ? bfhi(a0) : bflo(a0), x1 = (j & 1) ? bfhi(a1) : bflo(a1), x2 = (j & 1) ? bfhi(a2) : bflo(a2);
            const float hh = w2[j] * x0 + w1[j] * x1 + w0[j] * x2 + bb[j]; o[j] = siluf(hh) * up[j]; }
          u32x4 w; w.x = cvt_pk_bf16(o[0], o[1]); w.y = cvt_pk_bf16(o[2], o[3]); w.z = cvt_pk_bf16(o[4], o[5]); w.w = cvt_pk_bf16(o[6], o[7]);
          *(u32x4*)(O + (size_t)r * DFF + c) = w; } }
  }
};
struct EpiDown {
  static constexpr bool PERM = false;
  float* C;
  __device__ __forceinline__ void operator()(const f32x4 (&acc)[2][2][4][2], const Unit& u, int wr, int wc, int fr, int fq) const {
    const int row0 = u.pm * BM + wr * 64 + fr, col0 = u.pn * BM + wc * 32 + 4 * fq;
#pragma unroll
    for (int ai = 0; ai < 2; ++ai)
#pragma unroll
      for (int m = 0; m < 4; ++m) { float* rowp = C + (size_t)(row0 + ai * HALF + m * 16) * DM + col0;
#pragma unroll
        for (int bj = 0; bj < 2; ++bj)
#pragma unroll
          for (int n = 0; n < 2; ++n) { const f32x4 h = *(const f32x4*)(rowp + bj * HALF + n * 16); *(f32x4*)(rowp + bj * HALF + n * 16) = acc[ai][bj][m][n] + h * ALPHA; } }
  }
};
}

__device__ __forceinline__ void transpose_item(const float* W, int K, int ldw, int N, bf16_t* WT, LAS float* scr, int item, int lane) {
  const int nblk = N / 32, kb = item / nblk, nb = item % nblk, k0 = 64 * kb, n0 = 32 * nb;
#pragma unroll 8
  for (int i = 0; i < 32; ++i) { const int kk = 2 * i + (lane >> 5); scr[kk * 33 + (lane & 31)] = W[(size_t)(k0 + kk) * ldw + n0 + (lane & 31)]; }
  LDS_WAIT();
  const int c = lane & 7;
#pragma unroll
  for (int j = 0; j < 4; ++j) { const int n = (lane >> 3) + 8 * j; const LAS float* s = scr + (8 * c) * 33 + n;
    u32x4 o; o.x = cvt_pk_bf16(s[0 * 33], s[1 * 33]); o.y = cvt_pk_bf16(s[2 * 33], s[3 * 33]); o.z = cvt_pk_bf16(s[4 * 33], s[5 * 33]); o.w = cvt_pk_bf16(s[6 * 33], s[7 * 33]);
    *(u32x4*)(WT + (size_t)(n0 + n) * K + k0 + 8 * c) = o; }
  LDS_WAIT();
}
__device__ __forceinline__ void transpose_all(const float* W, int K, int ldw, int N, bf16_t* WT, LAS unsigned char* lds, int gw, int ngw, int wave, int lane) {
  LAS float* scr = (LAS float*)(lds + wave * 16384);
  const int nitems = (K / 64) * (N / 32);
  for (int it = gw; it < nitems; it += ngw) transpose_item(W, K, ldw, N, WT, scr, it, lane);
}

__device__ __forceinline__ void p0_rows(const KArgs& a, int gw, int ngw, int lane) {
  const float* x = a.in[0]; const float* meta = a.in[1]; const float* win = a.in[2];
  bf16_t* H0 = (bf16_t*)(a.ws + WS_H0); float* BA = (float*)(a.ws + WS_BA);
  for (int r = gw; r < R; r += ngw) {
    const int b = r / LPAD, p = r - b * LPAD, t = p - FPAD;
    u32x2* orow = (u32x2*)(H0 + (size_t)r * DM);
    if (t < 0) {
#pragma unroll
      for (int i = 0; i < 8; ++i) orow[lane + 64 * i] = (u32x2){0u, 0u};
      if (lane < 16) BA[(size_t)r * 16 + lane] = 0.f;
      continue;
    }
    const float* src = t < NMETA ? meta + (size_t)t * DM : x + ((size_t)b * SEQ + (t - NMETA)) * DM;
    float acc[16];
#pragma unroll
    for (int j = 0; j < 16; ++j) acc[j] = 0.f;
#pragma unroll 2
    for (int i = 0; i < 8; ++i) {
      const f32x4 v = *(const f32x4*)(src + 4 * lane + 256 * i);
      orow[lane + 64 * i] = (u32x2){cvt_pk_bf16(v[0], v[1]), cvt_pk_bf16(v[2], v[3])};
#pragma unroll
      for (int e = 0; e < 4; ++e) { const float* wr = win + (size_t)(4 * lane + 256 * i + e) * INCOLS + NPROJ;
#pragma unroll
        for (int q = 0; q < 4; ++q) { const f32x4 w = *(const f32x4*)(wr + 4 * q);
          acc[4 * q + 0] += v[e] * w[0]; acc[4 * q + 1] += v[e] * w[1]; acc[4 * q + 2] += v[e] * w[2]; acc[4 * q + 3] += v[e] * w[3]; } }
    }
#pragma unroll
    for (int j = 0; j < 16; ++j) acc[j] = wave_sum(acc[j]);
    float mine = 0.f;
#pragma unroll
    for (int j = 0; j < 16; ++j) mine = (lane == j) ? acc[j] : mine;
    if (lane < 16) BA[(size_t)r * 16 + lane] = mine;
  }
}

__device__ const double ROPE_INVF[32] = {1.0, 0.7498942093324559, 0.5623413251903491, 0.4216965034285822, 0.31622776601683794, 0.23713737056616552, 0.1778279410038923, 0.1333521432163324, 0.1, 0.07498942093324558, 0.05623413251903491, 0.042169650342858224, 0.03162277660168379, 0.023713737056616554, 0.01778279410038923, 0.01333521432163324, 0.01, 0.007498942093324558, 0.005623413251903491, 0.004216965034285823, 0.0031622776601683794, 0.0023713737056616554, 0.0017782794100389228, 0.001333521432163324, 0.001, 0.0007498942093324559, 0.0005623413251903491, 0.00042169650342858224, 0.00031622776601683794, 0.00023713737056616554, 0.00017782794100389227, 0.0001333521432163324};
constexpr float QSCALE = 0.18033688011112042f;
__device__ __forceinline__ void sincos_red(double ang, float& s, float& c) {
  const double n = __builtin_rint(ang * 0.15915494309189535);
  const float r = (float)__builtin_fma(-n, 6.283185307179586, ang);
  s = __sinf(r); c = __cosf(r);
}
__device__ __forceinline__ void p2_rope(const KArgs& a, int gw, int ngw, int lane) {
  const bf16_t* P = (const bf16_t*)(a.ws + WS_P);
  bf16_t* QR = (bf16_t*)(a.ws + WS_QR); bf16_t* KR = (bf16_t*)(a.ws + WS_KR);
  const int ip = lane & 15;
  const double f0 = ROPE_INVF[2 * ip], f1 = ROPE_INVF[2 * ip + 1];
  for (int r = gw; r < R; r += ngw) {
    const int p = r % LPAD, t = p - FPAD;
    float s0, c0, s1, c1; sincos_red((double)t * f0, s0, c0); sincos_red((double)t * f1, s1, c1);
#pragma unroll
    for (int j = 0; j < 8; ++j) {
      const int grp = (lane >> 4) + 4 * j;
      const bf16_t* src = P + (size_t)r * NPROJ + grp * 64 + 2 * ip;
      const unsigned lo = *(const unsigned*)src, hi = *(const unsigned*)(src + 32);
      const float x1a = bflo(lo), x1b = bfhi(lo), x2a = bflo(hi), x2b = bfhi(hi);
      const float sc = grp < 16 ? QSCALE : 1.f;
      const float o1a = (x1a * c0 - x2a * s0) * sc, o1b = (x1b * c1 - x2b * s1) * sc, o2a = (x2a * c0 + x1a * s0) * sc, o2b = (x2b * c1 + x1b * s1) * sc;
      bf16_t* dst = (grp < 16 ? QR + (size_t)r * 1024 + grp * 64 : KR + (size_t)r * 1024 + (grp - 16) * 64) + 2 * ip;
      *(unsigned*)dst = cvt_pk_bf16(o1a, o1b); *(unsigned*)(dst + 32) = cvt_pk_bf16(o2a, o2b);
    }
  }
}

__device__ __forceinline__ int perm_k32(int k) { return 8 * ((k & 15) >> 2) + 4 * (k >> 4) + (k & 3); }
constexpr int PR_QN = 0, PR_KN = 17408, PR_RHS = 34816, PR_MT = 100352, PR_GC = 116736, PR_BETA = PR_GC + 256;
__device__ __forceinline__ void prep_item(const KArgs& a, LAS unsigned char* lds, int item) {
  const int tid = threadIdx.x, lane = tid & 63, wave = __builtin_amdgcn_readfirstlane(tid >> 6);
  const int bh = item / NCH, ch = item - bh * NCH, b = bh >> 3, h = bh & 7;
  const int r0 = b * LPAD + ch * 64;
  const bf16_t* P = (const bf16_t*)(a.ws + WS_P);
  const float* BA = (const float*)(a.ws + WS_BA);
  unsigned char* ib = a.ws + WS_PREP + (size_t)item * PREP_ITEM;
  bf16_t* gW = (bf16_t*)ib; bf16_t* gQD = (bf16_t*)(ib + 16384); bf16_t* gKDT = (bf16_t*)(ib + 32768); bf16_t* gUT = (bf16_t*)(ib + 49152); bf16_t* gQK = (bf16_t*)(ib + 65536);
  LAS float* gcs = (LAS float*)(lds + PR_GC); LAS float* betas = (LAS float*)(lds + PR_BETA);
  LAS float* rhs = (LAS float*)(lds + PR_RHS); LAS float* MT = (LAS float*)(lds + PR_MT);
  if (wave == 0) {
    const int t = ch * 64 + lane - FPAD;
    float beta = 0.f, gg = 0.f;
    if (t >= 0) {
      const float br = BA[(size_t)(r0 + lane) * 16 + h], ar = BA[(size_t)(r0 + lane) * 16 + 8 + h];
      beta = 1.f / (1.f + expf(-br));
      const float z = ar + a.in[5][h];
      const float sp = z > 20.f ? z : log1pf(expf(z));
      gg = -expf(a.in[4][h]) * sp;
    }
    float v = gg;
#pragma unroll
    for (int o = 1; o < 64; o <<= 1) { const float u = __shfl_up(v, o); if (lane >= o) v += u; }
    gcs[lane] = v; betas[lane] = beta;
    if (lane == 63) ((float*)(a.ws + WS_GL))[item] = expf(v);
  }
  __syncthreads();
  {
    const int i = tid >> 3, seg = tid & 7, d0 = seg * 16;
    const float gci = gcs[i], gcl = gcs[63], bi = betas[i];
    const float eg = expf(gci), egl = expf(gcl - gci);
    float val[3][16];
#pragma unroll
    for (int T = 0; T < 3; ++T) {
      const int ccol = T * 1024 + h * 128 + d0;
      float acc[16];
#pragma unroll
      for (int e = 0; e < 16; ++e) acc[e] = 0.f;
#pragma unroll
      for (int j = 0; j < 4; ++j) {
        const int pr = ch * 64 + i - 3 + j;
        if (pr >= 0) {
          const bf16_t* src = P + (size_t)(r0 + i - 3 + j) * NPROJ + 3072 + ccol;
          const u32x4 x0 = *(const u32x4*)src, x1 = *(const u32x4*)(src + 8);
          const float* cw = a.in[3] + (size_t)j * 3072 + ccol;
#pragma unroll
          for (int e = 0; e < 4; ++e) { acc[2 * e] += bflo(x0[e]) * cw[2 * e]; acc[2 * e + 1] += bfhi(x0[e]) * cw[2 * e + 1];
            acc[8 + 2 * e] += bflo(x1[e]) * cw[8 + 2 * e]; acc[8 + 2 * e + 1] += bfhi(x1[e]) * cw[8 + 2 * e + 1]; }
        }
      }
      float ss = 0.f;
#pragma unroll
      for (int e = 0; e < 16; ++e) { acc[e] = siluf(acc[e]); ss += acc[e] * acc[e]; }
      if (T < 2) {
        ss += __shfl_xor(ss, 1); ss += __shfl_xor(ss, 2); ss += __shfl_xor(ss, 4);
        const float rn = rsqrtf(ss + 1e-6f) * (T == 0 ? 0.08838834764831845f : 1.f);
#pragma unroll
        for (int e = 0; e < 16; ++e) acc[e] *= rn;
      }
#pragma unroll
      for (int e = 0; e < 16; ++e) val[T][e] = acc[e];
    }
    {
      u32x4 w0, w1;
      w0.x = cvt_pk_bf16(val[0][0], val[0][1]); w0.y = cvt_pk_bf16(val[0][2], val[0][3]); w0.z = cvt_pk_bf16(val[0][4], val[0][5]); w0.w = cvt_pk_bf16(val[0][6], val[0][7]);
      w1.x = cvt_pk_bf16(val[0][8], val[0][9]); w1.y = cvt_pk_bf16(val[0][10], val[0][11]); w1.z = cvt_pk_bf16(val[0][12], val[0][13]); w1.w = cvt_pk_bf16(val[0][14], val[0][15]);
      *(LAS u32x4*)(lds + PR_QN + i * 272 + d0 * 2) = w0; *(LAS u32x4*)(lds + PR_QN + i * 272 + d0 * 2 + 16) = w1;
      w0.x = cvt_pk_bf16(val[1][0], val[1][1]); w0.y = cvt_pk_bf16(val[1][2], val[1][3]); w0.z = cvt_pk_bf16(val[1][4], val[1][5]); w0.w = cvt_pk_bf16(val[1][6], val[1][7]);
      w1.x = cvt_pk_bf16(val[1][8], val[1][9]); w1.y = cvt_pk_bf16(val[1][10], val[1][11]); w1.z = cvt_pk_bf16(val[1][12], val[1][13]); w1.w = cvt_pk_bf16(val[1][14], val[1][15]);
      *(LAS u32x4*)(lds + PR_KN + i * 272 + d0 * 2) = w0; *(LAS u32x4*)(lds + PR_KN + i * 272 + d0 * 2 + 16) = w1;
    }
    {
      const int blk = 32 * (seg >> 1), h1 = seg & 1;
#pragma unroll
      for (int g4 = 0; g4 < 4; ++g4) {
        u32x2 w; w.x = cvt_pk_bf16(val[0][4 * g4] * eg, val[0][4 * g4 + 1] * eg); w.y = cvt_pk_bf16(val[0][4 * g4 + 2] * eg, val[0][4 * g4 + 3] * eg);
        *(u32x2*)(gQD + (size_t)i * 128 + blk + 8 * g4 + 4 * h1) = w;
      }
    }
    {
      const int pi = 32 * (i >> 5) + perm_k32(i & 31);
#pragma unroll
      for (int e = 0; e < 16; ++e) gKDT[(size_t)(d0 + e) * 64 + pi] = f2bf(val[1][e] * egl);
    }
#pragma unroll
    for (int q4 = 0; q4 < 4; ++q4) {
      *(LAS f32x4*)(rhs + i * 256 + d0 + 4 * q4) = (f32x4){val[2][4 * q4] * bi, val[2][4 * q4 + 1] * bi, val[2][4 * q4 + 2] * bi, val[2][4 * q4 + 3] * bi};
      const float kb = bi * eg;
      *(LAS f32x4*)(rhs + i * 256 + 128 + d0 + 4 * q4) = (f32x4){val[1][4 * q4] * kb, val[1][4 * q4 + 1] * kb, val[1][4 * q4 + 2] * kb, val[1][4 * q4 + 3] * kb};
    }
  }
  __syncthreads();
  {
    const int it = wave >> 1, fr = lane & 15, g = lane >> 4;
#pragma unroll
    for (int s2 = 0; s2 < 2; ++s2) {
      const int st = 2 * (wave & 1) + s2;
      f32x4 am = {0.f, 0.f, 0.f, 0.f}, aq = {0.f, 0.f, 0.f, 0.f};
      if (st <= it) {
#pragma unroll
        for (int ks = 0; ks < 4; ++ks) {
          const bf16x8 ak = *(const LAS bf16x8*)(lds + PR_KN + (it * 16 + fr) * 272 + (32 * ks + 8 * g) * 2);
          const bf16x8 aqf = *(const LAS bf16x8*)(lds + PR_QN + (it * 16 + fr) * 272 + (32 * ks + 8 * g) * 2);
          const bf16x8 bk = *(const LAS bf16x8*)(lds + PR_KN + (st * 16 + fr) * 272 + (32 * ks + 8 * g) * 2);
          am = __builtin_amdgcn_mfma_f32_16x16x32_bf16(ak, bk, am, 0, 0, 0);
          aq = __builtin_amdgcn_mfma_f32_16x16x32_bf16(aqf, bk, aq, 0, 0, 0);
        }
      }
      const int s = st * 16 + fr; const float gs = gcs[s];
      f32x4 mo;
#pragma unroll
      for (int rg = 0; rg < 4; ++rg) {
        const int i = it * 16 + 4 * g + rg;
        const float dec = i >= s ? expf(gcs[i] - gs) : 0.f;
        mo[rg] = i > s ? betas[i] * am[rg] * dec : 0.f;
        gQK[(size_t)i * 64 + 32 * (s >> 5) + perm_k32(s & 31)] = f2bf(aq[rg] * dec);
      }
      *(LAS f32x4*)(MT + s * 64 + it * 16 + 4 * g) = mo;
    }
  }
  __syncthreads();
  if (tid < 256) {
    float X[64];
#pragma unroll
    for (int i = 0; i < 64; ++i) X[i] = rhs[i * 256 + tid];
#pragma unroll
    for (int s = 0; s < 63; ++s) {
      const float xs = X[s];
#pragma unroll
      for (int i4 = (s + 1) & ~3; i4 < 64; i4 += 4) {
        const f32x4 mv = *(const LAS f32x4*)(MT + s * 64 + i4);
#pragma unroll
        for (int e = 0; e < 4; ++e) if (i4 + e > s) X[i4 + e] -= mv[e] * xs;
      }
    }
    if (tid < 128) {
#pragma unroll
      for (int q8 = 0; q8 < 8; ++q8) {
        u32x4 w; w.x = cvt_pk_bf16(X[8 * q8], X[8 * q8 + 1]); w.y = cvt_pk_bf16(X[8 * q8 + 2], X[8 * q8 + 3]); w.z = cvt_pk_bf16(X[8 * q8 + 4], X[8 * q8 + 5]); w.w = cvt_pk_bf16(X[8 * q8 + 6], X[8 * q8 + 7]);
        *(u32x4*)(gUT + (size_t)tid * 64 + 8 * q8) = w;
      }
    } else {
      const int k = tid - 128, pk = 32 * (k >> 5) + perm_k32(k & 31);
#pragma unroll
      for (int i = 0; i < 64; ++i) gW[(size_t)i * 128 + pk] = f2bf(-X[i]);
    }
  }
  __syncthreads();
}

constexpr int SC_W = 0, SC_QD = 17408, SC_KDT = 34816, SC_QK = 53248, SC_O = 62464;
__device__ __forceinline__ bf16x8 pack8(const f32x4 a, const f32x4 b) {
  u32x4 w; w.x = cvt_pk_bf16(a[0], a[1]); w.y = cvt_pk_bf16(a[2], a[3]); w.z = cvt_pk_bf16(b[0], b[1]); w.w = cvt_pk_bf16(b[2], b[3]);
  return __builtin_bit_cast(bf16x8, w);
}
__device__ __forceinline__ void scan_bh(const KArgs& a, LAS unsigned char* lds, int bh) {
  const int tid = threadIdx.x, lane = tid & 63, wave = __builtin_amdgcn_readfirstlane(tid >> 6), fr = lane & 15, g = lane >> 4;
  const int b = bh >> 3, h = bh & 7;
  bf16_t* P = (bf16_t*)(a.ws + WS_P);
  const float* GL = (const float*)(a.ws + WS_GL);
  const float* dnw = a.in[11];
  f32x4 accS[8];
#pragma unroll
  for (int kt = 0; kt < 8; ++kt) accS[kt] = (f32x4){0.f, 0.f, 0.f, 0.f};
  u32x4 st[7]; u32x2 ut[4];
#define SC_LOAD(n) do { const unsigned char* ib_ = a.ws + WS_PREP + (size_t)(bh * NCH + (n)) * PREP_ITEM; \
    st[0] = *(const u32x4*)(ib_ + (size_t)tid * 16); st[1] = *(const u32x4*)(ib_ + (size_t)(tid + 512) * 16); \
    st[2] = *(const u32x4*)(ib_ + 16384 + (size_t)tid * 16); st[3] = *(const u32x4*)(ib_ + 16384 + (size_t)(tid + 512) * 16); \
    st[4] = *(const u32x4*)(ib_ + 32768 + (size_t)tid * 16); st[5] = *(const u32x4*)(ib_ + 32768 + (size_t)(tid + 512) * 16); \
    st[6] = *(const u32x4*)(ib_ + 65536 + (size_t)tid * 16); \
    _Pragma("unroll") for (int ct_ = 0; ct_ < 4; ++ct_) ut[ct_] = *(const u32x2*)(ib_ + 49152 + ((size_t)(16 * wave + fr) * 64 + 16 * ct_ + 4 * g) * 2); } while (0)
#define SC_STORE() do { \
    *(LAS u32x4*)(lds + SC_W + (tid >> 4) * 272 + (tid & 15) * 16) = st[0]; *(LAS u32x4*)(lds + SC_W + ((tid >> 4) + 32) * 272 + (tid & 15) * 16) = st[1]; \
    *(LAS u32x4*)(lds + SC_QD + (tid >> 4) * 272 + (tid & 15) * 16) = st[2]; *(LAS u32x4*)(lds + SC_QD + ((tid >> 4) + 32) * 272 + (tid & 15) * 16) = st[3]; \
    *(LAS u32x4*)(lds + SC_KDT + (tid >> 3) * 144 + (tid & 7) * 16) = st[4]; *(LAS u32x4*)(lds + SC_KDT + ((tid >> 3) + 64) * 144 + (tid & 7) * 16) = st[5]; \
    *(LAS u32x4*)(lds + SC_QK + (tid >> 3) * 144 + (tid & 7) * 16) = st[6]; } while (0)
  SC_LOAD(0);
  __syncthreads();
  SC_STORE();
  __syncthreads();
  for (int n = 0; n < NCH; ++n) {
    const float gl = GL[bh * NCH + n];
    f32x4 accV[4];
#pragma unroll
    for (int ct = 0; ct < 4; ++ct) accV[ct] = (f32x4){bflo(ut[ct].x), bfhi(ut[ct].x), bflo(ut[ct].y), bfhi(ut[ct].y)};
    if (n + 1 < NCH) SC_LOAD(n + 1);
    bf16x8 Sf[4];
#pragma unroll
    for (int ks = 0; ks < 4; ++ks) Sf[ks] = pack8(accS[2 * ks], accS[2 * ks + 1]);
    f32x4 accO[4];
#pragma unroll
    for (int ct = 0; ct < 4; ++ct) {
      accO[ct] = (f32x4){0.f, 0.f, 0.f, 0.f};
#pragma unroll
      for (int ks = 0; ks < 4; ++ks) {
        const bf16x8 aw = *(const LAS bf16x8*)(lds + SC_W + (16 * ct + fr) * 272 + (32 * ks + 8 * g) * 2);
        const bf16x8 aq = *(const LAS bf16x8*)(lds + SC_QD + (16 * ct + fr) * 272 + (32 * ks + 8 * g) * 2);
        accV[ct] = __builtin_amdgcn_mfma_f32_16x16x32_bf16(aw, Sf[ks], accV[ct], 0, 0, 0);
        accO[ct] = __builtin_amdgcn_mfma_f32_16x16x32_bf16(aq, Sf[ks], accO[ct], 0, 0, 0);
      }
    }
    bf16x8 Vf[2];
    Vf[0] = pack8(accV[0], accV[1]); Vf[1] = pack8(accV[2], accV[3]);
#pragma unroll
    for (int ct = 0; ct < 4; ++ct)
#pragma unroll
      for (int ks = 0; ks < 2; ++ks) {
        const bf16x8 aqk = *(const LAS bf16x8*)(lds + SC_QK + (16 * ct + fr) * 144 + (32 * ks + 8 * g) * 2);
        accO[ct] = __builtin_amdgcn_mfma_f32_16x16x32_bf16(aqk, Vf[ks], accO[ct], 0, 0, 0);
      }
#pragma unroll
    for (int kt = 0; kt < 8; ++kt) {
      accS[kt] = accS[kt] * gl;
#pragma unroll
      for (int ks = 0; ks < 2; ++ks) {
        const bf16x8 akd = *(const LAS bf16x8*)(lds + SC_KDT + (16 * kt + fr) * 144 + (32 * ks + 8 * g) * 2);
        accS[kt] = __builtin_amdgcn_mfma_f32_16x16x32_bf16(akd, Vf[ks], accS[kt], 0, 0, 0);
      }
    }
#pragma unroll
    for (int ct = 0; ct < 4; ++ct)
#pragma unroll
      for (int rg = 0; rg < 4; ++rg) *(LAS float*)(lds + SC_O + ((16 * ct + 4 * g + rg) * 132 + 16 * wave + fr) * 4) = accO[ct][rg];
    __syncthreads();
    {
      const int c = tid >> 3, seg = tid & 7;
      const size_t row = (size_t)b * LPAD + n * 64 + c;
      float o[16]; float ss = 0.f;
#pragma unroll
      for (int q4 = 0; q4 < 4; ++q4) { const f32x4 v = *(const LAS f32x4*)(lds + SC_O + (c * 132 + 16 * seg + 4 * q4) * 4); o[4 * q4] = v[0]; o[4 * q4 + 1] = v[1]; o[4 * q4 + 2] = v[2]; o[4 * q4 + 3] = v[3]; }
#pragma unroll
      for (int e = 0; e < 16; ++e) ss += o[e] * o[e];
      ss += __shfl_xor(ss, 1); ss += __shfl_xor(ss, 2); ss += __shfl_xor(ss, 4);
      const float rstd = rsqrtf(ss * (1.f / 128.f) + 1e-6f);
      const bf16_t* dz = P + row * NPROJ + 6144 + h * 128 + 16 * seg;
      const u32x4 z0 = *(const u32x4*)dz, z1 = *(const u32x4*)(dz + 8);
      float zz[16];
#pragma unroll
      for (int e = 0; e < 4; ++e) { zz[2 * e] = bflo(z0[e]); zz[2 * e + 1] = bfhi(z0[e]); zz[8 + 2 * e] = bflo(z1[e]); zz[8 + 2 * e + 1] = bfhi(z1[e]); }
#pragma unroll
      for (int e = 0; e < 16; ++e) o[e] = o[e] * rstd * dnw[16 * seg + e] * siluf(zz[e]);
      u32x4 w0, w1;
      w0.x = cvt_pk_bf16(o[0], o[1]); w0.y = cvt_pk_bf16(o[2], o[3]); w0.z = cvt_pk_bf16(o[4], o[5]); w0.w = cvt_pk_bf16(o[6], o[7]);
      w1.x = cvt_pk_bf16(o[8], o[9]); w1.y = cvt_pk_bf16(o[10], o[11]); w1.z = cvt_pk_bf16(o[12], o[13]); w1.w = cvt_pk_bf16(o[14], o[15]);
      bf16_t* dst = P + row * NPROJ + 1024 + h * 128 + 16 * seg;
      *(u32x4*)dst = w0; *(u32x4*)(dst + 8) = w1;
    }
    if (n + 1 < NCH) SC_STORE();
    __syncthreads();
  }
#undef SC_LOAD
#undef SC_STORE
}

constexpr int AT_K1 = 0, AT_K2 = 9216, AT_V = 18432, AT_O = 34816;
__device__ __forceinline__ unsigned voff_b(unsigned row, unsigned ch) { return 256u * row + 16u * (ch ^ (((row & 3) << 2) | ((row >> 2) & 3))); }
__device__ __forceinline__ s16x4 tr_read(LAS unsigned char* p) { s16x4 r; asm volatile("ds_read_b64_tr_b16 %0, %1\n\ts_waitcnt lgkmcnt(0)" : "=&v"(r) : "v"((unsigned)(size_t)p) : "memory"); return r; }
__device__ __forceinline__ void attn_item(const KArgs& a, LAS unsigned char* lds, int bh, int j, float lam) {
  const int tid = threadIdx.x, lane = tid & 63, wave = __builtin_amdgcn_readfirstlane(tid >> 6), fr = lane & 15, g = lane >> 4;
  const int b = bh >> 3, h = bh & 7, comp = wave >> 2, wq = wave & 3;
  const bf16_t* QR = (const bf16_t*)(a.ws + WS_QR); const bf16_t* KR = (const bf16_t*)(a.ws + WS_KR);
  bf16_t* P = (bf16_t*)(a.ws + WS_P);
  const size_t rb = (size_t)b * LPAD;
  const size_t qrow = rb + j * 64 + 16 * wq + fr;
  bf16x8 Qf[2];
#pragma unroll
  for (int ks = 0; ks < 2; ++ks) Qf[ks] = *(const bf16x8*)(QR + qrow * 1024 + h * 128 + comp * 64 + 32 * ks + 8 * g);
  f32x4 accO[8];
#pragma unroll
  for (int et = 0; et < 8; ++et) accO[et] = (f32x4){0.f, 0.f, 0.f, 0.f};
  float m = -INFINITY, lsum = 0.f;
  u32x4 sk1, sk2, sv0, sv1;
  const int krow = tid >> 3, kch = tid & 7;
  const int vrow0 = tid >> 4, vch = tid & 15;
#define AT_LOAD(kt) do { const size_t kr_ = rb + (size_t)(kt) * 64; \
    sk1 = *(const u32x4*)(KR + (kr_ + krow) * 1024 + h * 128 + kch * 8); sk2 = *(const u32x4*)(KR + (kr_ + krow) * 1024 + h * 128 + 64 + kch * 8); \
    sv0 = *(const u32x4*)(P + (kr_ + vrow0) * NPROJ + 2048 + h * 128 + vch * 8); sv1 = *(const u32x4*)(P + (kr_ + vrow0 + 32) * NPROJ + 2048 + h * 128 + vch * 8); } while (0)
#define AT_STORE() do { *(LAS u32x4*)(lds + AT_K1 + krow * 144 + kch * 16) = sk1; *(LAS u32x4*)(lds + AT_K2 + krow * 144 + kch * 16) = sk2; \
    *(LAS u32x4*)(lds + AT_V + voff_b(vrow0, vch)) = sv0; *(LAS u32x4*)(lds + AT_V + voff_b(vrow0 + 32, vch)) = sv1; } while (0)
  AT_LOAD(0);
  __syncthreads();
  AT_STORE();
  __syncthreads();
  LAS unsigned char* kbase = lds + (comp ? AT_K2 : AT_K1);
  for (int kt = 0; kt <= j; ++kt) {
    if (kt < j) AT_LOAD(kt + 1);
    f32x4 s[4];
#pragma unroll
    for (int nt = 0; nt < 4; ++nt) {
      s[nt] = (f32x4){0.f, 0.f, 0.f, 0.f};
#pragma unroll
      for (int ks = 0; ks < 2; ++ks) {
        const bf16x8 kf = *(const LAS bf16x8*)(kbase + (16 * nt + fr) * 144 + (32 * ks + 8 * g) * 2);
        s[nt] = __builtin_amdgcn_mfma_f32_16x16x32_bf16(kf, Qf[ks], s[nt], 0, 0, 0);
      }
    }
    if (kt == 0) {
#pragma unroll
      for (int nt = 0; nt < 3; ++nt) s[nt] = (f32x4){-INFINITY, -INFINITY, -INFINITY, -INFINITY};
    }
    float mx = -INFINITY;
#pragma unroll
    for (int nt = 0; nt < 4; ++nt)
#pragma unroll
      for (int rg = 0; rg < 4; ++rg) mx = fmaxf(mx, s[nt][rg]);
    mx = fmaxf(mx, __shfl_xor(mx, 16)); mx = fmaxf(mx, __shfl_xor(mx, 32));
    const float mn = fmaxf(m, mx);
    const float al = exp2f(m - mn);
    float rs = 0.f;
#pragma unroll
    for (int nt = 0; nt < 4; ++nt)
#pragma unroll
      for (int rg = 0; rg < 4; ++rg) { const float p = exp2f(s[nt][rg] - mn); s[nt][rg] = p; rs += p; }
    rs += __shfl_xor(rs, 16); rs += __shfl_xor(rs, 32);
    lsum = lsum * al + rs; m = mn;
#pragma unroll
    for (int et = 0; et < 8; ++et) accO[et] = accO[et] * al;
    bf16x8 Pf[2];
    Pf[0] = pack8(s[0], s[1]); Pf[1] = pack8(s[2], s[3]);
#pragma unroll
    for (int ks = 0; ks < 2; ++ks)
#pragma unroll
      for (int et = 0; et < 8; ++et) {
        const unsigned q4 = (unsigned)fr >> 2, p4 = (unsigned)fr & 3;
        const unsigned rowA = 32u * ks + 4u * g + q4, chv = 2u * et + (p4 >> 1);
        const s16x4 v0 = tr_read(lds + AT_V + voff_b(rowA, chv) + 8u * (p4 & 1));
        const s16x4 v1 = tr_read(lds + AT_V + voff_b(rowA + 16u, chv) + 8u * (p4 & 1));
        bf16x8 vf; vf[0] = v0[0]; vf[1] = v0[1]; vf[2] = v0[2]; vf[3] = v0[3]; vf[4] = v1[0]; vf[5] = v1[1]; vf[6] = v1[2]; vf[7] = v1[3];
        accO[et] = __builtin_amdgcn_mfma_f32_16x16x32_bf16(vf, Pf[ks], accO[et], 0, 0, 0);
      }
    __syncthreads();
    if (kt < j) AT_STORE();
    __syncthreads();
  }
  const float inv = 1.f / lsum;
#pragma unroll
  for (int et = 0; et < 8; ++et) accO[et] = accO[et] * inv;
  LAS float* ob = (LAS float*)(lds + AT_O) + (wq * 16 + fr) * 132;
  if (comp == 1) {
#pragma unroll
    for (int et = 0; et < 8; ++et) *(LAS f32x4*)(ob + 16 * et + 4 * g) = accO[et];
  }
  __syncthreads();
  if (comp == 0) {
    float ss = 0.f;
#pragma unroll
    for (int et = 0; et < 8; ++et) { const f32x4 o2 = *(const LAS f32x4*)(ob + 16 * et + 4 * g); accO[et] = accO[et] - o2 * lam;
      ss += accO[et][0] * accO[et][0] + accO[et][1] * accO[et][1] + accO[et][2] * accO[et][2] + accO[et][3] * accO[et][3]; }
    ss += __shfl_xor(ss, 16); ss += __shfl_xor(ss, 32);
    const float rstd = rsqrtf(ss * (1.f / 128.f) + 1e-6f) * (1.f - LAM_INIT);
    const float* nw = a.in[10];
#pragma unroll
    for (int et = 0; et < 8; ++et) { const f32x4 w4 = *(const f32x4*)(nw + 16 * et + 4 * g);
      u32x2 w; w.x = cvt_pk_bf16(accO[et][0] * rstd * w4[0], accO[et][1] * rstd * w4[1]); w.y = cvt_pk_bf16(accO[et][2] * rstd * w4[2], accO[et][3] * rstd * w4[3]);
      *(u32x2*)(P + qrow * NPROJ + h * 128 + 16 * et + 4 * g) = w; }
  }
  __syncthreads();
#undef AT_LOAD
#undef AT_STORE
}

__device__ __forceinline__ void ln1_rows(const KArgs& a, int gw, int ngw, int lane) {
  const float* PRE = (const float*)(a.ws + WS_PRE1); bf16_t* H1B = (bf16_t*)(a.ws + WS_H1B);
  const float* gam = a.in[13]; const float* bet = a.in[14];
  for (int r = gw; r < R; r += ngw) {
    const int b = r / LPAD, p = r - b * LPAD, t = p - FPAD;
    u32x2* orow = (u32x2*)(H1B + (size_t)r * DM);
    if (t < 0) {
#pragma unroll
      for (int i = 0; i < 8; ++i) orow[lane + 64 * i] = (u32x2){0u, 0u};
      continue;
    }
    const f32x4* xr = (const f32x4*)(PRE + (size_t)r * DM) + lane;
    f32x4 v[8]; float s = 0.f;
#pragma unroll
    for (int i = 0; i < 8; ++i) { v[i] = xr[64 * i]; s += (v[i][0] + v[i][1]) + (v[i][2] + v[i][3]); }
    const float mean = wave_sum(s) * (1.f / DM); float s2 = 0.f;
#pragma unroll
    for (int i = 0; i < 8; ++i) { v[i] = v[i] - mean; s2 += (v[i][0] * v[i][0] + v[i][1] * v[i][1]) + (v[i][2] * v[i][2] + v[i][3] * v[i][3]); }
    const float rstd = rsqrtf(wave_sum(s2) * (1.f / DM) + 1e-5f);
    float* of = t >= NMETA ? a.out + ((size_t)b * SEQ + (t - NMETA)) * DM : nullptr;
#pragma unroll
    for (int i = 0; i < 8; ++i) {
      const f32x4 gg = *((const f32x4*)gam + lane + 64 * i), bb = *((const f32x4*)bet + lane + 64 * i);
      const f32x4 y = v[i] * rstd * gg + bb;
      orow[lane + 64 * i] = (u32x2){cvt_pk_bf16(y[0], y[1]), cvt_pk_bf16(y[2], y[3])};
      if (of) *((f32x4*)of + lane + 64 * i) = y;
    }
  }
}
__device__ __forceinline__ void ln2_rows(const KArgs& a, int gw, int ngw, int lane) {
  const float* gam = a.in[20]; const float* bet = a.in[21];
  for (int r = gw; r < NB * SEQ; r += ngw) {
    f32x4* xr = (f32x4*)(a.out + (size_t)r * DM) + lane;
    f32x4 v[8]; float s = 0.f;
#pragma unroll
    for (int i = 0; i < 8; ++i) { v[i] = xr[64 * i]; s += (v[i][0] + v[i][1]) + (v[i][2] + v[i][3]); }
    const float mean = wave_sum(s) * (1.f / DM); float s2 = 0.f;
#pragma unroll
    for (int i = 0; i < 8; ++i) { v[i] = v[i] - mean; s2 += (v[i][0] * v[i][0] + v[i][1] * v[i][1]) + (v[i][2] * v[i][2] + v[i][3] * v[i][3]); }
    const float rstd = rsqrtf(wave_sum(s2) * (1.f / DM) + 1e-5f);
#pragma unroll
    for (int i = 0; i < 8; ++i) {
      const f32x4 gg = *((const f32x4*)gam + lane + 64 * i), bb = *((const f32x4*)bet + lane + 64 * i);
      f32x4 y = v[i] * rstd * gg + bb;
#ifdef DBG_NANFIX
      for (int e = 0; e < 4; ++e) if (!(y[e] == y[e]) || fabsf(y[e]) > 1e30f) y[e] = 1000.f;
#endif
      xr[64 * i] = y;
    }
  }
}

__global__ void __launch_bounds__(NTHR, 2) mega(KArgs a) {
  extern __shared__ __attribute__((aligned(16))) unsigned char lds_raw[];
  LAS unsigned char* lds = (LAS unsigned char*)lds_raw;
  cg::grid_group grid = cg::this_grid();
  const int tid = threadIdx.x, lane = tid & 63, wave = __builtin_amdgcn_readfirstlane(tid >> 6);
  const int G = gridDim.x, gw = blockIdx.x * NWAVE + wave, ngw = G * NWAVE;
  const int lo = a.ph_lo, hi = a.ph_hi;
#define IN(k) (lo <= (k) && (k) < hi)
#define SEAM(k) do { if (IN(k) && IN((k) + 1)) { asm volatile("s_waitcnt vmcnt(0) lgkmcnt(0)" ::: "memory"); __syncthreads(); grid.sync(); __builtin_amdgcn_fence(__ATOMIC_ACQUIRE, "agent"); asm volatile("s_waitcnt vmcnt(0)" ::: "memory"); __syncthreads(); } } while (0)
  if (IN(0)) {
    transpose_all(a.in[2], DM, INCOLS, NPROJ, (bf16_t*)(a.ws + WS_WINT), lds, gw, ngw, wave, lane);
    p0_rows(a, gw, ngw, lane);
  }
  SEAM(0);
  if (IN(1)) {
    pg8::Gemm g{(const bf16_t*)(a.ws + WS_H0), (const bf16_t*)(a.ws + WS_WINT), DM, DM, 0};
    pg8::StaticOrder S; S.init(R / 256, NPROJ / 256, G, (int)blockIdx.x);
    pg8::EpiBf16 E{(bf16_t*)(a.ws + WS_P), NPROJ};
    pg8::gemm_phase<pg8::EpiBf16>(lds, g, S, E);
  }
  SEAM(1);
  if (IN(2)) {
    p2_rope(a, gw, ngw, lane);
    transpose_all(a.in[12], DM, DM, DM, (bf16_t*)(a.ws + WS_WOUT), lds, gw, ngw, wave, lane);
    __syncthreads();
    for (int it = blockIdx.x; it < NB * 8 * NCH; it += G) prep_item(a, lds, it);
  }
  SEAM(2);
  if (IN(3)) {
    LAS int* qslot = (LAS int*)(lds + 147000);
    const float p1 = a.in[6][lane] * a.in[7][lane], p2 = a.in[8][lane] * a.in[9][lane];
    const float lam = expf(wave_sum(p1)) - expf(wave_sum(p2)) + LAM_INIT;
    if (blockIdx.x < NB * 8) scan_bh(a, lds, (int)blockIdx.x);
    unsigned* cnt = (unsigned*)(a.ws + WS_CNT);
    for (;;) {
      __syncthreads();
      if (tid == 0) *qslot = (int)atomicAdd(cnt, 1u);
      __syncthreads();
      const int q = *qslot;
      if (q >= NB * 8 * NCH) break;
      attn_item(a, lds, q & 31, (NCH - 1) - (q >> 5), lam);
    }
  }
  SEAM(3);
  if (IN(4)) {
    pg8::Gemm g{(const bf16_t*)(a.ws + WS_P), (const bf16_t*)(a.ws + WS_WOUT), NPROJ, DM, 0};
    pg8::StaticOrder S; S.init(R / 256, DM / 256, G, (int)blockIdx.x);
    pg8::EpiOutProj E{(float*)(a.ws + WS_PRE1), a.in[0], a.in[1]};
    pg8::gemm_phase<pg8::EpiOutProj>(lds, g, S, E);
  }
  SEAM(4);
  if (IN(5)) {
    ln1_rows(a, gw, ngw, lane);
    transpose_all(a.in[15], DM, DFF, DFF, (bf16_t*)(a.ws + WS_WG), lds, gw, ngw, wave, lane);
    transpose_all(a.in[16], DM, DFF, DFF, (bf16_t*)(a.ws + WS_WU), lds, gw, ngw, wave, lane);
  }
  SEAM(5);
  if (IN(6)) {
    pg8::Gemm g{(const bf16_t*)(a.ws + WS_H1B), (const bf16_t*)(a.ws + WS_WG), DM, DM, 0};
    pg8::StaticOrder S; S.init(R / 256, DFF / 256, G, (int)blockIdx.x);
    pg8::EpiBf16 E{(bf16_t*)(a.ws + WS_G), DFF};
    pg8::gemm_phase<pg8::EpiBf16>(lds, g, S, E);
  }
  SEAM(6);
  if (IN(7)) {
    pg8::Gemm g{(const bf16_t*)(a.ws + WS_H1B), (const bf16_t*)(a.ws + WS_WU), DM, DM, 0};
    pg8::StaticOrder S; S.init(R / 256, DFF / 256, G, (int)blockIdx.x);
    pg8::EpiUpAct E{(bf16_t*)(a.ws + WS_ACT), (const bf16_t*)(a.ws + WS_G), a.in[17], a.in[18]};
    pg8::gemm_phase<pg8::EpiUpAct>(lds, g, S, E);
    transpose_all(a.in[19], DFF, DM, DM, (bf16_t*)(a.ws + WS_WG), lds, gw, ngw, wave, lane);
  }
  SEAM(7);
  if (IN(8)) {
    pg8::Gemm g{(const bf16_t*)(a.ws + WS_ACT), (const bf16_t*)(a.ws + WS_WG), DFF, DFF, 1};
    pg8::StaticOrder S; S.init(NB * SEQ / 256, DM / 256, G, (int)blockIdx.x);
    pg8::EpiDown E{a.out};
    pg8::gemm_phase<pg8::EpiDown>(lds, g, S, E);
  }
  SEAM(8);
  if (IN(9)) ln2_rows(a, gw, ngw, lane);
}


#ifdef DBG_STAGE
__global__ void dbg_dump(const void* buf, size_t n, int isbf, size_t row_elems, size_t col_lo, size_t col_hi, float* out, size_t nout) {
  for (size_t i = (size_t)blockIdx.x * blockDim.x + threadIdx.x; i < nout; i += (size_t)gridDim.x * blockDim.x) {
    float flag = 0.f;
    for (size_t j = i; j < n; j += nout) {
      const size_t c = j % row_elems;
      if (c < col_lo || c >= col_hi) continue;
      const float v = isbf ? bf2f(((const bf16_t*)buf)[j]) : ((const float*)buf)[j];
      if (!(v == v) || fabsf(v) > 1e30f) flag = 1000.f;
    }
    out[i] = flag;
  }
}
#endif
extern "C" void kernel_launch(void* const* d_in, const int* in_sizes, int n_in, void* d_out, int out_size, void* d_ws, size_t ws_size, hipStream_t stream) {
  static int grid = 0;
  if (grid == 0) {
    int dev = 0, cus = 0, per_cu = 0;
    (void)hipGetDevice(&dev);
    (void)hipDeviceGetAttribute(&cus, hipDeviceAttributeMultiprocessorCount, dev);
    (void)hipFuncSetAttribute((const void*)mega, hipFuncAttributeMaxDynamicSharedMemorySize, LDS_BYTES);
    (void)hipOccupancyMaxActiveBlocksPerMultiprocessor(&per_cu, (const void*)mega, NTHR, LDS_BYTES);
    if (per_cu < 1) per_cu = 1;
    grid = cus * 1;
    if (n_in != 22 || ws_size < WS_END) { fprintf(stderr, "kernel_launch: bad sizes n_in %d ws %zu\n", n_in, ws_size); grid = -1; }
  }
  if (grid < 0) return;
  (void)hipMemsetAsync((char*)d_ws + WS_CNT, 0, 4096, stream);
  KArgs a{};
  for (int i = 0; i < 22; ++i) a.in[i] = (const float*)d_in[i];
  a.out = (float*)d_out; a.ws = (unsigned char*)d_ws; a.ph_lo = 0; a.ph_hi = 10;
#ifndef MK_SPLIT
#define MK_SPLIT 1
#endif
  hipError_t e = hipSuccess;
#if MK_SPLIT
#ifdef DBG_STAGE
  const int nph = DBG_STAGE + 1;
#else
  const int nph = 10;
#endif
  for (int ph = 0; ph < nph; ++ph) { a.ph_lo = ph; a.ph_hi = ph + 1; hipLaunchKernelGGL(mega, dim3(grid), dim3(NTHR), LDS_BYTES, stream, a); }
#ifdef DBG_STAGE
  { unsigned char* w = (unsigned char*)d_ws; float* o = (float*)d_out; const size_t no = (size_t)out_size;
    if (DBG_STAGE == 0) hipLaunchKernelGGL(dbg_dump, dim3(2048), dim3(256), 0, stream, (const void*)(w + WS_H0), (size_t)R * DM, 1, (size_t)DM, (size_t)0, (size_t)DM, o, no);
    if (DBG_STAGE == 1) hipLaunchKernelGGL(dbg_dump, dim3(2048), dim3(256), 0, stream, (const void*)(w + WS_P), (size_t)R * NPROJ, 1, (size_t)NPROJ, (size_t)0, (size_t)NPROJ, o, no);
    if (DBG_STAGE == 2) hipLaunchKernelGGL(dbg_dump, dim3(2048), dim3(256), 0, stream, (const void*)(w + WS_QR), (size_t)(WS_WOUT - WS_QR) / 2 + (size_t)DM * DM, 1, (size_t)64, (size_t)0, (size_t)64, o, no);
    if (DBG_STAGE == 3) hipLaunchKernelGGL(dbg_dump, dim3(2048), dim3(256), 0, stream, (const void*)(w + WS_P), (size_t)R * NPROJ, 1, (size_t)NPROJ, (size_t)DBG_CLO, (size_t)DBG_CHI, o, no);
    if (DBG_STAGE == 4) hipLaunchKernelGGL(dbg_dump, dim3(2048), dim3(256), 0, stream, (const void*)(w + WS_PRE1), (size_t)R * DM, 0, (size_t)DM, (size_t)0, (size_t)DM, o, no);
    if (DBG_STAGE == 5) hipLaunchKernelGGL(dbg_dump, dim3(2048), dim3(256), 0, stream, (const void*)(w + WS_H1B), (size_t)R * DM, 1, (size_t)DM, (size_t)0, (size_t)DM, o, no);
    if (DBG_STAGE == 6) hipLaunchKernelGGL(dbg_dump, dim3(2048), dim3(256), 0, stream, (const void*)(w + WS_G), (size_t)R * DFF, 1, (size_t)DFF, (size_t)0, (size_t)DFF, o, no);
    if (DBG_STAGE == 7) hipLaunchKernelGGL(dbg_dump, dim3(2048), dim3(256), 0, stream, (const void*)(w + WS_ACT), (size_t)R * DFF, 1, (size_t)DFF, (size_t)0, (size_t)DFF, o, no);
  }
#endif
  e = hipGetLastError();
#else
  void* args[] = {&a};
  e = hipLaunchCooperativeKernel((void*)mega, dim3(grid), dim3(NTHR), args, LDS_BYTES, stream);
#endif
  if (e != hipSuccess) fprintf(stderr, "cooperative launch failed: %s (grid %d)\n", hipGetErrorString(e), grid);
}
```

```cpp
#include <hip/hip_runtime.h>
#include <hip/hip_cooperative_groups.h>
#include <cstdio>
#define DBG_CLO 0
#define DBG_CHI 2048
namespace cg = cooperative_groups;

#define LAS __attribute__((address_space(3)))
typedef unsigned short bf16_t;
typedef short bf16x8 __attribute__((ext_vector_type(8)));
typedef short s16x4 __attribute__((ext_vector_type(4)));
typedef float f32x4 __attribute__((ext_vector_type(4)));
typedef float f32x2 __attribute__((ext_vector_type(2)));
typedef unsigned u32x4 __attribute__((ext_vector_type(4)));
typedef unsigned u32x2 __attribute__((ext_vector_type(2)));

constexpr int NB = 4, SEQ = 2048, NMETA = 16, LTOK = SEQ + NMETA, FPAD = 48, LPAD = LTOK + FPAD  , R = NB * LPAD  ;
constexpr int DM = 2048, NPROJ = 7168, INCOLS = 7184, DFF = 5632, NCH = LPAD / 64  ;
constexpr float ALPHA = 1.189207115002721f;
constexpr float LAM_INIT = 0.2f;
constexpr int NTHR = 512, NWAVE = 8;
constexpr int LDS_BYTES = 147456;

constexpr size_t MiB = 1u << 20;
constexpr size_t WS_BA = 0;
constexpr size_t WS_GL = 1 * MiB;
constexpr size_t WS_CNT = 2 * MiB;
constexpr size_t WS_P = 4 * MiB;
constexpr size_t WS_WINT = 120 * MiB;
constexpr size_t WS_H0 = 148 * MiB;
constexpr size_t WS_QR = 120 * MiB;
constexpr size_t WS_KR = WS_QR + (size_t)R * 1024 * 2;
constexpr size_t WS_PREP = 153 * MiB;
constexpr size_t PREP_ITEM = 73728;
constexpr size_t WS_WOUT = 228 * MiB;
constexpr size_t WS_PRE1 = 120 * MiB;
constexpr size_t WS_H1B = 186 * MiB;
constexpr size_t WS_G = 4 * MiB;
constexpr size_t WS_ACT = 95 * MiB;
constexpr size_t WS_WG = 219 * MiB;
constexpr size_t WS_WU = 241 * MiB;
constexpr size_t WS_END = 263 * MiB;
static_assert(WS_KR + (size_t)R * 1024 * 2 <= WS_PREP && WS_PREP + (size_t)NB * 8 * NCH * PREP_ITEM <= WS_WOUT, "ws map");
static_assert(WS_G + (size_t)R * DFF * 2 <= WS_ACT && WS_ACT + (size_t)R * DFF * 2 <= WS_H1B && WS_H1B + (size_t)R * DM * 2 <= WS_WG, "ws map 2");

typedef __bf16 bf16x2v __attribute__((ext_vector_type(2)));
__device__ __forceinline__ unsigned cvt_pk_bf16(float lo, float hi) { const f32x2 v = {lo, hi}; const bf16x2v b = __builtin_convertvector(v, bf16x2v); return __builtin_bit_cast(unsigned, b); }
__device__ __forceinline__ float bf2f(unsigned short b) { return __uint_as_float(((unsigned)b) << 16); }
__device__ __forceinline__ float bflo(unsigned w) { return __uint_as_float(w << 16); }
__device__ __forceinline__ float bfhi(unsigned w) { return __uint_as_float(w & 0xffff0000u); }
__device__ __forceinline__ bf16_t f2bf(float f) { return (bf16_t)(cvt_pk_bf16(f, 0.f) & 0xffffu); }
template <int CTRL> __device__ __forceinline__ float dpp_mov(float x) { return __uint_as_float((unsigned)__builtin_amdgcn_update_dpp(0, (int)__float_as_uint(x), CTRL, 0xF, 0xF, true)); }
__device__ __forceinline__ float wave_sum(float v) {
  v += dpp_mov<0xB1>(v);
  v += dpp_mov<0x4E>(v);
  v += dpp_mov<0x141>(v);
  v += dpp_mov<0x140>(v);
  { auto r = __builtin_amdgcn_permlane16_swap(__float_as_uint(v), __float_as_uint(v), false, false); v = __uint_as_float(r[0]) + __uint_as_float(r[1]); }
  { auto r = __builtin_amdgcn_permlane32_swap(__float_as_uint(v), __float_as_uint(v), false, false); v = __uint_as_float(r[0]) + __uint_as_float(r[1]); }
  return v;
}
__device__ __forceinline__ float siluf(float x) { return x * __builtin_amdgcn_rcpf(1.f + __expf(-x)); }
#define LDS_WAIT() asm volatile("s_waitcnt lgkmcnt(0)" ::: "memory")
#define LBAR() do { asm volatile("s_waitcnt lgkmcnt(0)" ::: "memory"); __builtin_amdgcn_s_barrier(); asm volatile("" ::: "memory"); } while (0)
__device__ __forceinline__ int fresh_lane() { int l; asm volatile("v_and_b32 %0, 63, %1" : "=v"(l) : "v"((int)threadIdx.x)); return l; }

struct KArgs { const float* in[22]; float* out; unsigned char* ws; int ph_lo, ph_hi; };

struct XcdBarrier;
__device__ __forceinline__ void xcd_barrier(const XcdBarrier& b);
namespace pg8 {
constexpr int BM = 256, BK = 64, HALF = 128, HTB = HALF * BK * 2, STAGE_BYTES = 8 * HTB, NXCD = 8, WGM = 8;
__host__ __device__ __forceinline__ int lds_byte(int r, int c) { const int st = (r >> 4) * 2 + (c >> 5), rr = r & 15, cc = c & 31, ob = rr * 64 + cc * 2; return st * 1024 + (ob ^ (((ob >> 9) & 1) << 5)); }
__host__ __device__ __forceinline__ void stage_rc(int b, int& Rr, int& C) { const int st = b / 1024, sb = b % 1024, swz = sb ^ (((sb >> 9) & 1) << 5); Rr = (st >> 1) * 16 + swz / 64; C = (st & 1) * 32 + (swz % 64) / 2; }
__host__ __device__ __forceinline__ int perm32(int rho) { const int n = rho >> 4, i = rho & 15; return 8 * (i >> 2) + 4 * n + (i & 3); }
struct Unit { int pm, pn; };
struct Gemm { const bf16_t* A; const bf16_t* Bt; int lda, K; int rowmap; };
__device__ __forceinline__ size_t a_row0(int rowmap, int pm) { return rowmap ? (size_t)((pm >> 3) * LPAD + 64 + (pm & 7) * 256) : (size_t)pm * 256; }
struct StaticOrder {
  int nM, nN, nwg, G, c;
  __device__ void init(int nM_, int nN_, int G_, int c_) { nM = nM_; nN = nN_; nwg = nM * nN; G = G_; c = c_; }
  __device__ bool next(int i, Unit& u) const {
    const long L = (long)i * G + c; if (L >= nwg) return false;
    int wgid = (int)L; { const int q = nwg / NXCD, r = nwg % NXCD, xcd = wgid % NXCD, off = wgid / NXCD; wgid = (xcd < r ? xcd * (q + 1) : r * (q + 1) + (xcd - r) * q) + off; }
    const int nig = WGM * nN, gid = wgid / nig, fm = gid * WGM, gsz = (nM - fm) < WGM ? (nM - fm) : WGM;
    u.pm = fm + ((wgid % nig) % gsz); u.pn = (wgid % nig) / gsz; return true;
  }
};

template <class Epi>
__device__ __forceinline__ void gemm_phase(LAS unsigned char* lds, const Gemm g, const StaticOrder& S, const Epi& E) {
  const int tid = threadIdx.x, wid = __builtin_amdgcn_readfirstlane(tid >> 6), lane = fresh_lane(), wr = wid >> 2, wc = wid & 3, fr = lane & 15, fq = lane >> 4;
  const int K = g.K, nt = K / BK, lda = g.lda;
  unsigned voffA[2], voffB[2];
#pragma unroll
  for (int i = 0; i < 2; ++i) { int Rr, C; stage_rc(tid * 16 + i * 8192, Rr, C); const int Rb = Epi::PERM ? ((Rr & ~31) + perm32(Rr & 31)) : Rr;
    voffA[i] = (unsigned)(Rr * lda + C) * 2u; voffB[i] = (unsigned)(Rb * K + C) * 2u; }
  const size_t kstep = (size_t)(BK * 2);
  const size_t hstepA = (size_t)HALF * lda * 2, hstepB = (size_t)HALF * K * 2;
  const unsigned ldsw = (unsigned)wid * 1024u;
  const int aoff = lds_byte(wr * 64 + fr, fq * 8), boff = lds_byte(wc * 32 + fr, fq * 8);
#define PG8_SA(b, h) (((b) * 2 + (h)) * HTB)
#define PG8_SB(b, h) ((4 + (b) * 2 + (h)) * HTB)
#define PG8_STAGE(bufoff, gbase, voff) do { _Pragma("unroll") for (int _i = 0; _i < 2; ++_i) \
    __builtin_amdgcn_global_load_lds((const unsigned*)((const char*)(gbase) + (voff)[_i]), (LAS unsigned*)(lds + (bufoff) + ldsw + _i * 8192), 16, 0, 0); } while (0)
#define PG8_LDA(dst, b, h) do { _Pragma("unroll") for (int m = 0; m < 4; ++m) _Pragma("unroll") for (int k = 0; k < 2; ++k) dst[m][k] = *(const LAS bf16x8*)(lds + PG8_SA(b, h) + aoff + m * 2048 + k * 1024); } while (0)
#define PG8_LDB(dst, b, h) do { _Pragma("unroll") for (int n = 0; n < 2; ++n) _Pragma("unroll") for (int k = 0; k < 2; ++k) dst[n][k] = *(const LAS bf16x8*)(lds + PG8_SB(b, h) + boff + n * 2048 + k * 1024); } while (0)
#define PG8_MMA(ai, bj, At, Bt) do { __builtin_amdgcn_s_setprio(1); _Pragma("unroll") for (int m = 0; m < 4; ++m) _Pragma("unroll") for (int n = 0; n < 2; ++n) _Pragma("unroll") for (int k = 0; k < 2; ++k) \
    acc[ai][bj][m][n] = __builtin_amdgcn_mfma_f32_16x16x32_bf16(Bt[n][k], At[m][k], acc[ai][bj][m][n], 0, 0, 0); __builtin_amdgcn_s_setprio(0); } while (0)
#define PG8_WAIT_V(n) asm volatile("s_waitcnt vmcnt(" #n ")" ::: "memory")
#define PG8_WAIT_L(n) asm volatile("s_waitcnt lgkmcnt(" #n ")" ::: "memory")
#define PG8_BAR __builtin_amdgcn_s_barrier()
#define PG8_SCHED __builtin_amdgcn_sched_barrier(0)
  Unit cur, nxt; int ui = 0;
  if (!S.next(0, cur)) return;
  f32x4 acc[2][2][4][2];
#pragma unroll
  for (int a = 0; a < 2; ++a)
#pragma unroll
    for (int b = 0; b < 2; ++b)
#pragma unroll
      for (int m = 0; m < 4; ++m)
#pragma unroll
        for (int n = 0; n < 2; ++n) acc[a][b][m][n] = (f32x4){0.f, 0.f, 0.f, 0.f};
  bf16x8 At[4][2], B0[2][2], B1[2][2];
  const char* cA = (const char*)g.A + a_row0(g.rowmap, cur.pm) * lda * 2; const char* cB = (const char*)g.Bt + (size_t)cur.pn * 2 * hstepB;
  PG8_STAGE(PG8_SB(0, 0), cB, voffB); PG8_STAGE(PG8_SA(0, 0), cA, voffA); PG8_STAGE(PG8_SB(0, 1), cB + hstepB, voffB); PG8_STAGE(PG8_SA(0, 1), cA + hstepA, voffA);
  if (wr == 1) PG8_BAR;
  PG8_WAIT_V(4); PG8_BAR;
  PG8_STAGE(PG8_SB(1, 0), cB + kstep, voffB); PG8_STAGE(PG8_SA(1, 0), cA + kstep, voffA); PG8_STAGE(PG8_SB(1, 1), cB + hstepB + kstep, voffB);
  PG8_WAIT_V(6); PG8_BAR;
  for (;;) {
    const bool has_next = S.next(ui + 1, nxt);
    const char* nA = has_next ? (const char*)g.A + a_row0(g.rowmap, nxt.pm) * lda * 2 : cA; const char* nB = has_next ? (const char*)g.Bt + (size_t)nxt.pn * 2 * hstepB : cB;
    for (int t = 0; t < nt; t += 2) {
      const bool last = (t == nt - 2);
      const char* a1 = cA + (size_t)(t + 1) * kstep;
      const char* a2 = last ? nA : cA + (size_t)(t + 2) * kstep; const char* b2 = last ? nB : cB + (size_t)(t + 2) * kstep;
      const char* a3 = a2 + kstep; const char* b3 = b2 + kstep;
      PG8_LDB(B0, 0, 0); PG8_SCHED; PG8_LDA(At, 0, 0); PG8_STAGE(PG8_SA(1, 1), a1 + hstepA, voffA);
      PG8_WAIT_L(8); PG8_BAR; PG8_WAIT_L(0); PG8_MMA(0, 0, At, B0); PG8_BAR; PG8_SCHED;
      PG8_LDB(B1, 0, 1); PG8_STAGE(PG8_SB(0, 0), b2, voffB);
      PG8_BAR; PG8_WAIT_L(0); PG8_MMA(0, 1, At, B1); PG8_BAR;
      PG8_LDA(At, 0, 1); PG8_STAGE(PG8_SA(0, 0), a2, voffA);
      PG8_BAR; PG8_WAIT_L(0); PG8_MMA(1, 0, At, B0); PG8_BAR; PG8_SCHED;
      PG8_STAGE(PG8_SB(0, 1), b2 + hstepB, voffB);
      PG8_WAIT_V(6); PG8_BAR; PG8_MMA(1, 1, At, B1); PG8_BAR;
      PG8_LDB(B0, 1, 0); PG8_SCHED; PG8_LDA(At, 1, 0); PG8_STAGE(PG8_SA(0, 1), a2 + hstepA, voffA);
      PG8_WAIT_L(8); PG8_BAR; PG8_WAIT_L(0); PG8_MMA(0, 0, At, B0); PG8_BAR; PG8_SCHED;
      PG8_LDB(B1, 1, 1); PG8_STAGE(PG8_SB(1, 0), b3, voffB);
      PG8_BAR; PG8_WAIT_L(0); PG8_MMA(0, 1, At, B1); PG8_BAR;
      PG8_LDA(At, 1, 1); PG8_STAGE(PG8_SA(1, 0), a3, voffA);
      PG8_BAR; PG8_WAIT_L(0); PG8_MMA(1, 0, At, B0); PG8_BAR; PG8_SCHED;
      PG8_STAGE(PG8_SB(1, 1), b3 + hstepB, voffB);
      PG8_WAIT_V(6); PG8_BAR; PG8_MMA(1, 1, At, B1); PG8_BAR;
    }
    if constexpr (!Epi::AFTER_DRAIN) E(acc, cur, wr, wc, fr, fq);
    if (!has_next) break;
#pragma unroll
    for (int a = 0; a < 2; ++a)
#pragma unroll
      for (int b = 0; b < 2; ++b)
#pragma unroll
        for (int m = 0; m < 4; ++m)
#pragma unroll
          for (int n = 0; n < 2; ++n) acc[a][b][m][n] = (f32x4){0.f, 0.f, 0.f, 0.f};
    cur = nxt; cA = nA; cB = nB; ++ui;
  }
  PG8_WAIT_V(0);
  if (wr == 0) PG8_BAR;
  PG8_BAR;
  if constexpr (Epi::AFTER_DRAIN) E.fused(acc, cur, wr, wc, fr, fq, lds);
#undef PG8_SA
#undef PG8_SB
#undef PG8_STAGE
#undef PG8_LDA
#undef PG8_LDB
#undef PG8_MMA
#undef PG8_WAIT_V
#undef PG8_WAIT_L
#undef PG8_BAR
#undef PG8_SCHED
}

struct EpiBf16 {
  static constexpr bool PERM = true, AFTER_DRAIN = false;
  bf16_t* O; int ldc;
  __device__ __forceinline__ void operator()(const f32x4 (&acc)[2][2][4][2], const Unit& u, int wr, int wc, int fr, int fq) const {
    const int row0 = u.pm * BM + wr * 64 + fr, col0 = u.pn * BM + wc * 32 + 8 * fq;
#pragma unroll
    for (int ai = 0; ai < 2; ++ai)
#pragma unroll
      for (int m = 0; m < 4; ++m) { bf16_t* rowp = O + (size_t)(row0 + ai * HALF + m * 16) * ldc + col0;
#pragma unroll
        for (int bj = 0; bj < 2; ++bj) { const f32x4 v0 = acc[ai][bj][m][0], v1 = acc[ai][bj][m][1];
          u32x4 w; w.x = cvt_pk_bf16(v0[0], v0[1]); w.y = cvt_pk_bf16(v0[2], v0[3]); w.z = cvt_pk_bf16(v1[0], v1[1]); w.w = cvt_pk_bf16(v1[2], v1[3]);
          *(u32x4*)(rowp + bj * HALF) = w; } }
  }
};
struct EpiOutProj {
  static constexpr bool PERM = false, AFTER_DRAIN = false;
  float* C; const float* x;
  __device__ __forceinline__ void operator()(const f32x4 (&acc)[2][2][4][2], const Unit& u, int wr, int wc, int fr, int fq) const {
    const int l0 = wr * 64 + fr, col0 = u.pn * BM + wc * 32 + 4 * fq;
    const size_t brow = a_row0(1, u.pm);
#pragma unroll
    for (int ai = 0; ai < 2; ++ai)
#pragma unroll
      for (int m = 0; m < 4; ++m) { const int l = l0 + ai * HALF + m * 16;
        const float* src = x + ((size_t)u.pm * BM + l) * DM + col0;
        float* rowp = C + (brow + l) * DM + col0;
#pragma unroll
        for (int bj = 0; bj < 2; ++bj)
#pragma unroll
          for (int n = 0; n < 2; ++n) { const f32x4 h = *(const f32x4*)(src + bj * HALF + n * 16); *(f32x4*)(rowp + bj * HALF + n * 16) = acc[ai][bj][m][n] + h * ALPHA; } }
  }
};
struct EpiUpAct {
  static constexpr bool PERM = true, AFTER_DRAIN = false;
  bf16_t* O; const bf16_t* G; const float* cw; const float* cb;
  __device__ __forceinline__ void operator()(const f32x4 (&acc)[2][2][4][2], const Unit& u, int wr, int wc, int fr, int fq) const {
    const int row0 = u.pm * BM + wr * 64 + fr, col0 = u.pn * BM + wc * 32 + 8 * fq;
#pragma unroll
    for (int bj = 0; bj < 2; ++bj) { const int c = col0 + bj * HALF;
      float w0[8], w1[8], w2[8], bb[8];
#pragma unroll
      for (int j = 0; j < 8; ++j) { w0[j] = cw[c + j]; w1[j] = cw[DFF + c + j]; w2[j] = cw[2 * DFF + c + j]; bb[j] = cb[c + j]; }
#pragma unroll
      for (int ai = 0; ai < 2; ++ai)
#pragma unroll
        for (int m = 0; m < 4; ++m) { const int r = row0 + ai * HALF + m * 16; const int r1 = r > 0 ? r - 1 : 0, r2 = r > 1 ? r - 2 : 0;
          const u32x4 g0 = *(const u32x4*)(G + (size_t)r * DFF + c), g1 = *(const u32x4*)(G + (size_t)r1 * DFF + c), g2 = *(const u32x4*)(G + (size_t)r2 * DFF + c);
          const f32x4 v0 = acc[ai][bj][m][0], v1 = acc[ai][bj][m][1];
          float up[8] = {v0[0], v0[1], v0[2], v0[3], v1[0], v1[1], v1[2], v1[3]}, o[8];
#pragma unroll
          for (int j = 0; j < 8; ++j) { const unsigned a0 = g0[j >> 1], a1 = g1[j >> 1], a2 = g2[j >> 1];
            const float x0 = (j & 1) ? bfhi(a0) : bflo(a0), x1 = (j & 1) ? bfhi(a1) : bflo(a1), x2 = (j & 1) ? bfhi(a2) : bflo(a2);
            const float hh = w2[j] * x0 + w1[j] * x1 + w0[j] * x2 + bb[j]; o[j] = siluf(hh) * up[j]; }
          u32x4 w; w.x = cvt_pk_bf16(o[0], o[1]); w.y = cvt_pk_bf16(o[2], o[3]); w.z = cvt_pk_bf16(o[4], o[5]); w.w = cvt_pk_bf16(o[6], o[7]);
          *(u32x4*)(O + (size_t)r * DFF + c) = w; } }
  }
};
struct EpiDown {
  static constexpr bool PERM = false, AFTER_DRAIN = false;
  float* C;
  __device__ __forceinline__ void operator()(const f32x4 (&acc)[2][2][4][2], const Unit& u, int wr, int wc, int fr, int fq) const {
    const int row0 = u.pm * BM + wr * 64 + fr, col0 = u.pn * BM + wc * 32 + 4 * fq;
#pragma unroll
    for (int ai = 0; ai < 2; ++ai)
#pragma unroll
      for (int m = 0; m < 4; ++m) { float* rowp = C + (size_t)(row0 + ai * HALF + m * 16) * DM + col0;
#pragma unroll
        for (int bj = 0; bj < 2; ++bj)
#pragma unroll
          for (int n = 0; n < 2; ++n) { const f32x4 h = *(const f32x4*)(rowp + bj * HALF + n * 16); *(f32x4*)(rowp + bj * HALF + n * 16) = acc[ai][bj][m][n] + h * ALPHA; } }
  }
};

struct EpiDownLN {
  static constexpr bool PERM = false, AFTER_DRAIN = true;
  float* C; const float* gam; const float* bet; unsigned long long* slots; unsigned* cnt;
  __device__ __forceinline__ void fused(f32x4 (&acc)[2][2][4][2], const Unit& u, int wr, int wc, int fr, int fq, LAS unsigned char* lds) const {
    const int tid = threadIdx.x;
    const int row0 = u.pm * BM + wr * 64 + fr, col0 = u.pn * BM + wc * 32 + 4 * fq;
    LAS f32x2* part = (LAS f32x2*)lds;
    LAS f32x2* stat = (LAS f32x2*)(lds + 8192);
#pragma unroll
    for (int ai = 0; ai < 2; ++ai)
#pragma unroll
      for (int m = 0; m < 4; ++m) { const float* rowp = C + (size_t)(row0 + ai * HALF + m * 16) * DM + col0;
        float s1 = 0.f, s2 = 0.f;
#pragma unroll
        for (int bj = 0; bj < 2; ++bj)
#pragma unroll
          for (int n = 0; n < 2; ++n) { const f32x4 h = *(const f32x4*)(rowp + bj * HALF + n * 16); const f32x4 v = acc[ai][bj][m][n] + h * ALPHA; acc[ai][bj][m][n] = v;
            s1 += (v[0] + v[1]) + (v[2] + v[3]); s2 += (v[0] * v[0] + v[1] * v[1]) + (v[2] * v[2] + v[3] * v[3]); }
        s1 += __shfl_xor(s1, 16); s1 += __shfl_xor(s1, 32); s2 += __shfl_xor(s2, 16); s2 += __shfl_xor(s2, 32);
        if (fq == 0) part[(ai * HALF + wr * 64 + m * 16 + fr) * 4 + wc] = (f32x2){s1, s2};
      }
    __syncthreads();
    if (tid < 256) {
      const f32x2 p0 = part[tid * 4 + 0], p1 = part[tid * 4 + 1], p2 = part[tid * 4 + 2], p3 = part[tid * 4 + 3];
      const float t1 = (p0.x + p1.x) + (p2.x + p3.x), t2 = (p0.y + p1.y) + (p2.y + p3.y);
      __hip_atomic_store(slots + ((size_t)(u.pm * BM + tid) * 8 + u.pn), ((unsigned long long)__float_as_uint(t2) << 32) | __float_as_uint(t1), __ATOMIC_RELAXED, __HIP_MEMORY_SCOPE_AGENT);
    }
    asm volatile("s_waitcnt vmcnt(0)" ::: "memory");
    __syncthreads();
    if (tid == 0) {
      __hip_atomic_fetch_add(cnt + 64 * u.pm, 1u, __ATOMIC_RELAXED, __HIP_MEMORY_SCOPE_AGENT);
      unsigned sp = 0;
      while (__hip_atomic_load(cnt + 64 * u.pm, __ATOMIC_RELAXED, __HIP_MEMORY_SCOPE_AGENT) < 8u) { __builtin_amdgcn_s_sleep(1); if (++sp > (1u << 22)) break; }
      __builtin_amdgcn_fence(__ATOMIC_ACQUIRE, "agent");
      asm volatile("s_waitcnt vmcnt(0)" ::: "memory");
    }
    __syncthreads();
    if (tid < 256) {
      float t1 = 0.f, t2 = 0.f;
#pragma unroll
      for (int t = 0; t < 8; ++t) { const unsigned long long w = __hip_atomic_load(slots + ((size_t)(u.pm * BM + tid) * 8 + t), __ATOMIC_RELAXED, __HIP_MEMORY_SCOPE_AGENT);
        t1 += __uint_as_float((unsigned)w); t2 += __uint_as_float((unsigned)(w >> 32)); }
      const float mean = t1 * (1.f / DM);
      const float var = fmaxf(t2 * (1.f / DM) - mean * mean, 0.f);
      stat[tid] = (f32x2){mean, rsqrtf(var + 1e-5f)};
    }
    __syncthreads();
    f32x4 gv[2][2], bv[2][2];
#pragma unroll
    for (int bj = 0; bj < 2; ++bj)
#pragma unroll
      for (int n = 0; n < 2; ++n) { gv[bj][n] = *(const f32x4*)(gam + col0 + bj * HALF + n * 16); bv[bj][n] = *(const f32x4*)(bet + col0 + bj * HALF + n * 16); }
#pragma unroll
    for (int ai = 0; ai < 2; ++ai)
#pragma unroll
      for (int m = 0; m < 4; ++m) { const f32x2 st = stat[ai * HALF + wr * 64 + m * 16 + fr]; float* rowp = C + (size_t)(row0 + ai * HALF + m * 16) * DM + col0;
#pragma unroll
        for (int bj = 0; bj < 2; ++bj)
#pragma unroll
          for (int n = 0; n < 2; ++n) *(f32x4*)(rowp + bj * HALF + n * 16) = (acc[ai][bj][m][n] - st.x) * st.y * gv[bj][n] + bv[bj][n]; }
    __syncthreads();
  }
};
struct EpiOutProjLN {
  static constexpr bool PERM = false, AFTER_DRAIN = true;
  const float* x; float* hf; bf16_t* hb; const float* gam; const float* bet; unsigned long long* slots; unsigned* cnt; const XcdBarrier* xb;
  __device__ __forceinline__ void fused(f32x4 (&acc)[2][2][4][2], const Unit& u, int wr, int wc, int fr, int fq, LAS unsigned char* lds) const {
    const int tid = threadIdx.x;
    const int l0 = wr * 64 + fr, col0 = u.pn * BM + wc * 32 + 4 * fq;
    const size_t brow = a_row0(1, u.pm);
    LAS f32x2* part = (LAS f32x2*)lds;
    LAS f32x2* stat = (LAS f32x2*)(lds + 8192);
#pragma unroll
    for (int ai = 0; ai < 2; ++ai)
#pragma unroll
      for (int m = 0; m < 4; ++m) { const float* rowp = x + ((size_t)u.pm * BM + l0 + ai * HALF + m * 16) * DM + col0;
        float s1 = 0.f, s2 = 0.f;
#pragma unroll
        for (int bj = 0; bj < 2; ++bj)
#pragma unroll
          for (int n = 0; n < 2; ++n) { const f32x4 h = *(const f32x4*)(rowp + bj * HALF + n * 16); const f32x4 v = acc[ai][bj][m][n] + h * ALPHA; acc[ai][bj][m][n] = v;
            s1 += (v[0] + v[1]) + (v[2] + v[3]); s2 += (v[0] * v[0] + v[1] * v[1]) + (v[2] * v[2] + v[3] * v[3]); }
        s1 += __shfl_xor(s1, 16); s1 += __shfl_xor(s1, 32); s2 += __shfl_xor(s2, 16); s2 += __shfl_xor(s2, 32);
        if (fq == 0) part[(ai * HALF + l0 + m * 16) * 4 + wc] = (f32x2){s1, s2};
      }
    __syncthreads();
    if (tid < 256) {
      const f32x2 p0 = part[tid * 4 + 0], p1 = part[tid * 4 + 1], p2 = part[tid * 4 + 2], p3 = part[tid * 4 + 3];
      const float t1 = (p0.x + p1.x) + (p2.x + p3.x), t2 = (p0.y + p1.y) + (p2.y + p3.y);
      __hip_atomic_store(slots + ((size_t)(u.pm * BM + tid) * 8 + u.pn), ((unsigned long long)__float_as_uint(t2) << 32) | __float_as_uint(t1), __ATOMIC_RELAXED, __HIP_MEMORY_SCOPE_AGENT);
    }
    asm volatile("s_waitcnt vmcnt(0)" ::: "memory");
    __syncthreads();
    if (tid == 0) {
      __hip_atomic_fetch_add(cnt + 64 * u.pm, 1u, __ATOMIC_RELAXED, __HIP_MEMORY_SCOPE_AGENT);
      unsigned sp = 0;
      while (__hip_atomic_load(cnt + 64 * u.pm, __ATOMIC_RELAXED, __HIP_MEMORY_SCOPE_AGENT) < 8u) { __builtin_amdgcn_s_sleep(1); if (++sp > (1u << 22)) break; }
      __builtin_amdgcn_fence(__ATOMIC_ACQUIRE, "agent");
      asm volatile("s_waitcnt vmcnt(0)" ::: "memory");
    }
    __syncthreads();
    if (tid < 256) {
      float t1 = 0.f, t2 = 0.f;
#pragma unroll
      for (int t = 0; t < 8; ++t) { const unsigned long long w = __hip_atomic_load(slots + ((size_t)(u.pm * BM + tid) * 8 + t), __ATOMIC_RELAXED, __HIP_MEMORY_SCOPE_AGENT);
        t1 += __uint_as_float((unsigned)w); t2 += __uint_as_float((unsigned)(w >> 32)); }
      const float mean = t1 * (1.f / DM);
      const float var = fmaxf(t2 * (1.f / DM) - mean * mean, 0.f);
      stat[tid] = (f32x2){mean, rsqrtf(var + 1e-5f)};
    }
    __syncthreads();
    xcd_barrier(*xb);
    f32x4 gv[2][2], bv[2][2];
#pragma unroll
    for (int bj = 0; bj < 2; ++bj)
#pragma unroll
      for (int n = 0; n < 2; ++n) { gv[bj][n] = *(const f32x4*)(gam + col0 + bj * HALF + n * 16); bv[bj][n] = *(const f32x4*)(bet + col0 + bj * HALF + n * 16); }
#pragma unroll
    for (int ai = 0; ai < 2; ++ai)
#pragma unroll
      for (int m = 0; m < 4; ++m) { const int l = l0 + ai * HALF + m * 16; const f32x2 st = stat[l];
        float* fo = hf + ((size_t)u.pm * BM + l) * DM + col0; bf16_t* bo = hb + (brow + l) * DM + col0;
#pragma unroll
        for (int bj = 0; bj < 2; ++bj)
#pragma unroll
          for (int n = 0; n < 2; ++n) { const f32x4 y = (acc[ai][bj][m][n] - st.x) * st.y * gv[bj][n] + bv[bj][n];
            *(f32x4*)(fo + bj * HALF + n * 16) = y; *(u32x2*)(bo + bj * HALF + n * 16) = (u32x2){cvt_pk_bf16(y[0], y[1]), cvt_pk_bf16(y[2], y[3])}; } }
    __syncthreads();
  }
};
}

__device__ __forceinline__ void transpose_item(const float* W, int K, int ldw, int N, bf16_t* WT, LAS float* scr, int item, int lane) {
  const int nblk = N / 64, kb = item / nblk, nb = item % nblk, k0 = 64 * kb, n0 = 64 * nb;
  float tv[64];
#pragma unroll
  for (int i = 0; i < 64; ++i) tv[i] = __builtin_nontemporal_load(&W[(size_t)(k0 + i) * ldw + n0 + lane]);
#pragma unroll
  for (int i = 0; i < 64; ++i) scr[i * 65 + lane] = tv[i];
  LDS_WAIT();
  const int c = lane & 7;
#pragma unroll
  for (int j = 0; j < 8; ++j) { const int n = (lane >> 3) + 8 * j; const LAS float* s = scr + (8 * c) * 65 + n;
    u32x4 o; o.x = cvt_pk_bf16(s[0 * 65], s[1 * 65]); o.y = cvt_pk_bf16(s[2 * 65], s[3 * 65]); o.z = cvt_pk_bf16(s[4 * 65], s[5 * 65]); o.w = cvt_pk_bf16(s[6 * 65], s[7 * 65]);
    *(u32x4*)(WT + (size_t)(n0 + n) * K + k0 + 8 * c) = o; }
  LDS_WAIT();
}
__device__ __forceinline__ void transpose_all(const float* W, int K, int ldw, int N, bf16_t* WT, LAS unsigned char* lds, int gw, int ngw, int wave, int lane) {
  LAS float* scr = (LAS float*)(lds + wave * 16640);
  const int nitems = (K / 64) * (N / 64);
  for (int it = gw; it < nitems; it += ngw) transpose_item(W, K, ldw, N, WT, scr, it, lane);
}

__device__ __forceinline__ void transpose_dyn(unsigned* cnt, const float* W1, bf16_t* WT1, const float* W2, bf16_t* WT2, int K, int ldw, int N, LAS unsigned char* lds, int wave, int lane) {
  LAS float* scr = (LAS float*)(lds + wave * 16640);
  const int n1 = (K / 64) * (N / 64), total = W2 ? 2 * n1 : n1;
  for (;;) {
    int it0 = 0;
    if (lane == 0) it0 = (int)atomicAdd(cnt, 8u);
    it0 = __builtin_amdgcn_readfirstlane(it0);
    if (it0 >= total) break;
    for (int it = it0; it < it0 + 8 && it < total; ++it) {
      if (it < n1) transpose_item(W1, K, ldw, N, WT1, scr, it, lane); else transpose_item(W2, K, ldw, N, WT2, scr, it - n1, lane);
    }
  }
}

__device__ __forceinline__ void p0_rows(const KArgs& a, LAS unsigned char* lds, int gw, int ngw, int lane) {
  const float* x = a.in[0]; const float* meta = a.in[1]; const float* win = a.in[2];
  bf16_t* H0 = (bf16_t*)(a.ws + WS_H0); float* BA = (float*)(a.ws + WS_BA);
  LAS float* wT = (LAS float*)lds;
  for (int k = threadIdx.x; k < DM; k += NTHR) {
    const float* wr = win + (size_t)k * INCOLS + NPROJ;
#pragma unroll
    for (int q = 0; q < 4; ++q) { const f32x4 w = *(const f32x4*)(wr + 4 * q);
#pragma unroll
      for (int e = 0; e < 4; ++e) wT[(4 * q + e) * DM + k] = w[e]; }
  }
  __syncthreads();
  for (int r = gw; r < R; r += ngw) {
    const int b = r / LPAD, p = r - b * LPAD, t = p - FPAD;
    u32x2* orow = (u32x2*)(H0 + (size_t)r * DM);
    if (t < 0) {
#pragma unroll
      for (int i = 0; i < 8; ++i) orow[lane + 64 * i] = (u32x2){0u, 0u};
      if (lane < 16) BA[(size_t)r * 16 + lane] = 0.f;
      continue;
    }
    const float* src = t < NMETA ? meta + (size_t)t * DM : x + ((size_t)b * SEQ + (t - NMETA)) * DM;
    float acc[16];
#pragma unroll
    for (int j = 0; j < 16; ++j) acc[j] = 0.f;
    f32x4 v[8];
#pragma unroll
    for (int i = 0; i < 8; ++i) v[i] = *(const f32x4*)(src + 4 * lane + 256 * i);
#pragma unroll
    for (int i = 0; i < 8; ++i) {
      orow[lane + 64 * i] = (u32x2){cvt_pk_bf16(v[i][0], v[i][1]), cvt_pk_bf16(v[i][2], v[i][3])};
#pragma unroll
      for (int j = 0; j < 16; ++j) { const f32x4 w = *(const LAS f32x4*)(wT + j * DM + 4 * lane + 256 * i);
        acc[j] += (v[i][0] * w[0] + v[i][1] * w[1]) + (v[i][2] * w[2] + v[i][3] * w[3]); }
    }
#pragma unroll
    for (int j = 0; j < 16; ++j) acc[j] = wave_sum(acc[j]);
    float mine = 0.f;
#pragma unroll
    for (int j = 0; j < 16; ++j) mine = (lane == j) ? acc[j] : mine;
    if (lane < 16) BA[(size_t)r * 16 + lane] = mine;
  }
  __syncthreads();
}

__device__ const double ROPE_INVF[32] = {1.0, 0.7498942093324559, 0.5623413251903491, 0.4216965034285822, 0.31622776601683794, 0.23713737056616552, 0.1778279410038923, 0.1333521432163324, 0.1, 0.07498942093324558, 0.05623413251903491, 0.042169650342858224, 0.03162277660168379, 0.023713737056616554, 0.01778279410038923, 0.01333521432163324, 0.01, 0.007498942093324558, 0.005623413251903491, 0.004216965034285823, 0.0031622776601683794, 0.0023713737056616554, 0.0017782794100389228, 0.001333521432163324, 0.001, 0.0007498942093324559, 0.0005623413251903491, 0.00042169650342858224, 0.00031622776601683794, 0.00023713737056616554, 0.00017782794100389227, 0.0001333521432163324};
constexpr float QSCALE = 0.18033688011112042f;
__device__ __forceinline__ void sincos_red(double ang, float& s, float& c) {
  const double n = __builtin_rint(ang * 0.15915494309189535);
  const float r = (float)__builtin_fma(-n, 6.283185307179586, ang);
  s = __sinf(r); c = __cosf(r);
}
__device__ __forceinline__ void p2_rope(const KArgs& a, int gw, int ngw, int lane) {
  const bf16_t* P = (const bf16_t*)(a.ws + WS_P);
  bf16_t* QR = (bf16_t*)(a.ws + WS_QR); bf16_t* KR = (bf16_t*)(a.ws + WS_KR);
  const int ip = lane & 15;
  const double f0 = ROPE_INVF[2 * ip], f1 = ROPE_INVF[2 * ip + 1];
  for (int r = gw; r < R; r += ngw) {
    const int p = r % LPAD, t = p - FPAD;
    float s0, c0, s1, c1; sincos_red((double)t * f0, s0, c0); sincos_red((double)t * f1, s1, c1);
#pragma unroll
    for (int j = 0; j < 8; ++j) {
      const int grp = (lane >> 4) + 4 * j;
      const bf16_t* src = P + (size_t)r * NPROJ + grp * 64 + 2 * ip;
      const unsigned lo = *(const unsigned*)src, hi = *(const unsigned*)(src + 32);
      const float x1a = bflo(lo), x1b = bfhi(lo), x2a = bflo(hi), x2b = bfhi(hi);
      const float sc = grp < 16 ? QSCALE : 1.f;
      const float o1a = (x1a * c0 - x2a * s0) * sc, o1b = (x1b * c1 - x2b * s1) * sc, o2a = (x2a * c0 + x1a * s0) * sc, o2b = (x2b * c1 + x1b * s1) * sc;
      bf16_t* dst = (grp < 16 ? QR + (size_t)r * 1024 + grp * 64 : KR + (size_t)r * 1024 + (grp - 16) * 64) + 2 * ip;
      *(unsigned*)dst = cvt_pk_bf16(o1a, o1b); *(unsigned*)(dst + 32) = cvt_pk_bf16(o2a, o2b);
    }
  }
}

__device__ __forceinline__ int perm_k32(int k) { return 8 * ((k & 15) >> 2) + 4 * (k >> 4) + (k & 3); }
constexpr int PR_QN = 0, PR_KN = 17408, PR_RHS = 34816, PR_MT = 100352, PR_GC = 116736;
__device__ __forceinline__ void prep_stepA(const KArgs& a, LAS unsigned char* lds, int item, int slot, int lane) {
  const int bh = item / NCH, ch = item - bh * NCH, b = bh >> 3, h = bh & 7;
  const int r0 = b * LPAD + ch * 64;
  const float* BA = (const float*)(a.ws + WS_BA);
  LAS float* gcs = (LAS float*)(lds + PR_GC + slot * 512); LAS float* betas = gcs + 64;
  const int t = ch * 64 + lane - FPAD;
  float beta = 0.f, gg = 0.f;
  if (t >= 0) {
    const float br = BA[(size_t)(r0 + lane) * 16 + h], ar = BA[(size_t)(r0 + lane) * 16 + 8 + h];
    beta = 1.f / (1.f + expf(-br));
    const float z = ar + a.in[5][h];
    const float sp = z > 20.f ? z : log1pf(expf(z));
    gg = -expf(a.in[4][h]) * sp;
  }
  float v = gg;
#pragma unroll
  for (int o = 1; o < 64; o <<= 1) { const float u = __shfl_up(v, o); if (lane >= o) v += u; }
  gcs[lane] = v; betas[lane] = beta;
  if (lane == 63) ((float*)(a.ws + WS_GL))[item] = expf(v);
}
__device__ __forceinline__ void prep_item(const KArgs& a, LAS unsigned char* lds, int item, int slot, int next_item) {
  const int tid = threadIdx.x, lane = fresh_lane(), wave = __builtin_amdgcn_readfirstlane(tid >> 6);
  const int bh = item / NCH, ch = item - bh * NCH, b = bh >> 3, h = bh & 7;
  const int r0 = b * LPAD + ch * 64;
  const bf16_t* P = (const bf16_t*)(a.ws + WS_P);
  unsigned char* ib = a.ws + WS_PREP + (size_t)item * PREP_ITEM;
  bf16_t* gW = (bf16_t*)ib; bf16_t* gQD = (bf16_t*)(ib + 16384); bf16_t* gKDT = (bf16_t*)(ib + 32768); bf16_t* gUT = (bf16_t*)(ib + 49152); bf16_t* gQK = (bf16_t*)(ib + 65536);
  LAS float* gcs = (LAS float*)(lds + PR_GC + slot * 512); LAS float* betas = gcs + 64;
  LAS float* rhs = (LAS float*)(lds + PR_RHS); LAS float* MT = (LAS float*)(lds + PR_MT);
  float kdv[16];
  {
    const int i = tid >> 3, seg = tid & 7, d0 = seg * 16;
    const float gci = gcs[i], gcl = gcs[63], bi = betas[i];
    const float eg = expf(gci), egl = expf(gcl - gci);
    float val[3][16];
#pragma unroll
    for (int T = 0; T < 3; ++T) {
      const int ccol = T * 1024 + h * 128 + d0;
      float acc[16];
#pragma unroll
      for (int e = 0; e < 16; ++e) acc[e] = 0.f;
      u32x4 xq[4][2]; f32x4 cq[4][4];
#pragma unroll
      for (int j = 0; j < 4; ++j) {
        const int pr = ch * 64 + i - 3 + j;
        const bf16_t* src = P + (size_t)(pr >= 0 ? r0 + i - 3 + j : r0 + i) * NPROJ + 3072 + ccol;
        xq[j][0] = *(const u32x4*)src; xq[j][1] = *(const u32x4*)(src + 8);
        const float* cw = a.in[3] + (size_t)j * 3072 + ccol;
#pragma unroll
        for (int q = 0; q < 4; ++q) cq[j][q] = *(const f32x4*)(cw + 4 * q);
      }
      __builtin_amdgcn_sched_barrier(0);
#pragma unroll
      for (int j = 0; j < 4; ++j) {
        const float vj = (ch * 64 + i - 3 + j) >= 0 ? 1.f : 0.f;
#pragma unroll
        for (int e = 0; e < 4; ++e) {
          acc[2 * e] += bflo(xq[j][0][e]) * (cq[j][e >> 1][2 * (e & 1)] * vj); acc[2 * e + 1] += bfhi(xq[j][0][e]) * (cq[j][e >> 1][2 * (e & 1) + 1] * vj);
          acc[8 + 2 * e] += bflo(xq[j][1][e]) * (cq[j][2 + (e >> 1)][2 * (e & 1)] * vj); acc[8 + 2 * e + 1] += bfhi(xq[j][1][e]) * (cq[j][2 + (e >> 1)][2 * (e & 1) + 1] * vj);
        }
      }
      float ss = 0.f;
#pragma unroll
      for (int e = 0; e < 16; ++e) { acc[e] = siluf(acc[e]); ss += acc[e] * acc[e]; }
      if (T < 2) {
        ss += __shfl_xor(ss, 1); ss += __shfl_xor(ss, 2); ss += __shfl_xor(ss, 4);
        const float rn = rsqrtf(ss + 1e-6f) * (T == 0 ? 0.08838834764831845f : 1.f);
#pragma unroll
        for (int e = 0; e < 16; ++e) acc[e] *= rn;
      }
#pragma unroll
      for (int e = 0; e < 16; ++e) val[T][e] = acc[e];
    }
    {
      u32x4 w0, w1;
      w0.x = cvt_pk_bf16(val[0][0], val[0][1]); w0.y = cvt_pk_bf16(val[0][2], val[0][3]); w0.z = cvt_pk_bf16(val[0][4], val[0][5]); w0.w = cvt_pk_bf16(val[0][6], val[0][7]);
      w1.x = cvt_pk_bf16(val[0][8], val[0][9]); w1.y = cvt_pk_bf16(val[0][10], val[0][11]); w1.z = cvt_pk_bf16(val[0][12], val[0][13]); w1.w = cvt_pk_bf16(val[0][14], val[0][15]);
      *(LAS u32x4*)(lds + PR_QN + i * 272 + d0 * 2) = w0; *(LAS u32x4*)(lds + PR_QN + i * 272 + d0 * 2 + 16) = w1;
      w0.x = cvt_pk_bf16(val[1][0], val[1][1]); w0.y = cvt_pk_bf16(val[1][2], val[1][3]); w0.z = cvt_pk_bf16(val[1][4], val[1][5]); w0.w = cvt_pk_bf16(val[1][6], val[1][7]);
      w1.x = cvt_pk_bf16(val[1][8], val[1][9]); w1.y = cvt_pk_bf16(val[1][10], val[1][11]); w1.z = cvt_pk_bf16(val[1][12], val[1][13]); w1.w = cvt_pk_bf16(val[1][14], val[1][15]);
      *(LAS u32x4*)(lds + PR_KN + i * 272 + d0 * 2) = w0; *(LAS u32x4*)(lds + PR_KN + i * 272 + d0 * 2 + 16) = w1;
    }
    {
      const int blk = 32 * (seg >> 1), h1 = seg & 1;
#pragma unroll
      for (int g4 = 0; g4 < 4; ++g4) {
        u32x2 w; w.x = cvt_pk_bf16(val[0][4 * g4] * eg, val[0][4 * g4 + 1] * eg); w.y = cvt_pk_bf16(val[0][4 * g4 + 2] * eg, val[0][4 * g4 + 3] * eg);
        *(u32x2*)(gQD + (size_t)i * 128 + blk + 8 * g4 + 4 * h1) = w;
      }
    }
#pragma unroll
    for (int e = 0; e < 16; ++e) kdv[e] = val[1][e] * egl;
#pragma unroll
    for (int q4 = 0; q4 < 4; ++q4) {
      *(LAS f32x4*)(rhs + i * 256 + d0 + 4 * q4) = (f32x4){val[2][4 * q4] * bi, val[2][4 * q4 + 1] * bi, val[2][4 * q4 + 2] * bi, val[2][4 * q4 + 3] * bi};
      const float kb = bi * eg;
      *(LAS f32x4*)(rhs + i * 256 + 128 + d0 + 4 * q4) = (f32x4){val[1][4 * q4] * kb, val[1][4 * q4 + 1] * kb, val[1][4 * q4 + 2] * kb, val[1][4 * q4 + 3] * kb};
    }
  }
  LBAR();
  {
    const int it = wave >> 1, fr = lane & 15, g = lane >> 4;
#pragma unroll
    for (int s2 = 0; s2 < 2; ++s2) {
      const int st = 2 * (wave & 1) + s2;
      f32x4 am = {0.f, 0.f, 0.f, 0.f}, aq = {0.f, 0.f, 0.f, 0.f};
      if (st <= it) {
#pragma unroll
        for (int ks = 0; ks < 4; ++ks) {
          const bf16x8 ak = *(const LAS bf16x8*)(lds + PR_KN + (it * 16 + fr) * 272 + (32 * ks + 8 * g) * 2);
          const bf16x8 aqf = *(const LAS bf16x8*)(lds + PR_QN + (it * 16 + fr) * 272 + (32 * ks + 8 * g) * 2);
          const bf16x8 bk = *(const LAS bf16x8*)(lds + PR_KN + (st * 16 + fr) * 272 + (32 * ks + 8 * g) * 2);
          am = __builtin_amdgcn_mfma_f32_16x16x32_bf16(ak, bk, am, 0, 0, 0);
          aq = __builtin_amdgcn_mfma_f32_16x16x32_bf16(aqf, bk, aq, 0, 0, 0);
        }
      }
      const int s = st * 16 + fr; const float gs = gcs[s];
      f32x4 mo;
#pragma unroll
      for (int rg = 0; rg < 4; ++rg) {
        const int i = it * 16 + 4 * g + rg;
        const float dec = i >= s ? expf(gcs[i] - gs) : 0.f;
        mo[rg] = i > s ? betas[i] * am[rg] * dec : 0.f;
        gQK[(size_t)i * 64 + 32 * (s >> 5) + perm_k32(s & 31)] = f2bf(aq[rg] * dec);
      }
      *(LAS f32x4*)(MT + s * 64 + it * 16 + 4 * g) = mo;
    }
  }
  LBAR();
  {
    const int i = tid >> 3, d0 = (tid & 7) * 16, pi = 32 * (i >> 5) + perm_k32(i & 31);
#pragma unroll
    for (int e = 0; e < 16; ++e) *(LAS bf16_t*)(lds + PR_QN + ((d0 + e) * 64 + pi) * 2) = f2bf(kdv[e]);
  }
  LBAR();
  if (tid >= 256) {
#pragma unroll
    for (int q = 0; q < 4; ++q) { const int c = (tid - 256) + 256 * q; *(u32x4*)((unsigned char*)gKDT + (size_t)c * 16) = *(const LAS u32x4*)(lds + PR_QN + c * 16); }
  }
  if (wave == 4 && next_item >= 0) prep_stepA(a, lds, next_item, slot ^ 1, lane);
  if (tid < 256) {
    f32x4 Xv[16];
#define X(i) Xv[(i) >> 2][(i) & 3]
#pragma unroll
    for (int i = 0; i < 64; ++i) X(i) = rhs[i * 256 + tid];
    f32x4 cb0[8], cb1[8];
#define SOLVE_LOAD(buf, s, lo4) do { _Pragma("unroll") for (int q_ = 0; q_ < 8; ++q_) if ((lo4) + 4 * q_ + 3 > (s)) buf[q_] = *(const LAS f32x4*)(MT + (s) * 64 + (lo4) + 4 * q_); } while (0)
#define SOLVE_APPLY(buf, s, lo4) do { const float xs_ = X(s); const f32x4 xs4_ = {xs_, xs_, xs_, xs_}; _Pragma("unroll") for (int q_ = 0; q_ < 8; ++q_) if ((lo4) + 4 * q_ + 3 > (s)) Xv[((lo4) >> 2) + q_] = Xv[((lo4) >> 2) + q_] - buf[q_] * xs4_; } while (0)
    SOLVE_LOAD(cb0, 0, 0);
#pragma unroll
    for (int s = 0; s < 32; s += 2) {
      SOLVE_LOAD(cb1, s + 1, 0); __builtin_amdgcn_sched_barrier(0);
      SOLVE_APPLY(cb0, s, 0);
      if (s + 2 < 32) SOLVE_LOAD(cb0, s + 2, 0); __builtin_amdgcn_sched_barrier(0);
      SOLVE_APPLY(cb1, s + 1, 0);
    }
    SOLVE_LOAD(cb0, 0, 32);
#pragma unroll
    for (int s = 0; s < 32; s += 2) {
      SOLVE_LOAD(cb1, s + 1, 32); __builtin_amdgcn_sched_barrier(0);
      SOLVE_APPLY(cb0, s, 32);
      if (s + 2 < 32) SOLVE_LOAD(cb0, s + 2, 32); __builtin_amdgcn_sched_barrier(0);
      SOLVE_APPLY(cb1, s + 1, 32);
    }
    SOLVE_LOAD(cb0, 32, 32);
#pragma unroll
    for (int s = 32; s < 64; s += 2) {
      SOLVE_LOAD(cb1, s + 1 < 63 ? s + 1 : 62, 32); __builtin_amdgcn_sched_barrier(0);
      SOLVE_APPLY(cb0, s, 32);
      if (s + 2 < 64) SOLVE_LOAD(cb0, s + 2, 32); __builtin_amdgcn_sched_barrier(0);
      if (s + 1 < 63) SOLVE_APPLY(cb1, s + 1, 32);
    }
#undef SOLVE_LOAD
#undef SOLVE_APPLY
    if (tid < 128) {
      const int uw = tid >> 5, uvt = (tid >> 4) & 1, ufr = tid & 15;
#pragma unroll
      for (int ct = 0; ct < 4; ++ct)
#pragma unroll
        for (int g4 = 0; g4 < 4; ++g4) {
          u32x2 w; w.x = cvt_pk_bf16(X(16 * ct + 4 * g4), X(16 * ct + 4 * g4 + 1)); w.y = cvt_pk_bf16(X(16 * ct + 4 * g4 + 2), X(16 * ct + 4 * g4 + 3));
          *(u32x2*)((unsigned char*)gUT + (size_t)((((uw * 4 + ct) * 2 + uvt) * 64) + 16 * g4 + ufr) * 8) = w;
        }
    } else {
      const int k = tid - 128, pk = 32 * (k >> 5) + perm_k32(k & 31);
#pragma unroll
      for (int i = 0; i < 64; ++i) gW[(size_t)i * 128 + pk] = f2bf(-X(i));
    }
  }
#undef X
  LBAR();
}

constexpr int SC_W = 0, SC_QD = 17408, SC_KDT = 34816, SC_QK = 53248, SC_O = 62464, SC_OSZ = 33792, SC_GL = SC_O + 2 * SC_OSZ;
__device__ __forceinline__ bf16x8 pack8(const f32x4 a, const f32x4 b) {
  u32x4 w; w.x = cvt_pk_bf16(a[0], a[1]); w.y = cvt_pk_bf16(a[2], a[3]); w.z = cvt_pk_bf16(b[0], b[1]); w.w = cvt_pk_bf16(b[2], b[3]);
  return __builtin_bit_cast(bf16x8, w);
}
#define SC_BAR() do { asm volatile("s_waitcnt lgkmcnt(0)" ::: "memory"); __builtin_amdgcn_s_barrier(); asm volatile("" ::: "memory"); } while (0)
__device__ __forceinline__ void scan_bh(const KArgs& a, LAS unsigned char* lds, int bh) {
  const int tid = threadIdx.x, lane = fresh_lane(), wave = __builtin_amdgcn_readfirstlane(tid >> 6), fr = lane & 15, g = lane >> 4;
  const int b = bh >> 3, h = bh & 7;
  bf16_t* P = (bf16_t*)(a.ws + WS_P);
  const float* GL = (const float*)(a.ws + WS_GL);
  const float* dnw = a.in[11];
  LAS float* gls = (LAS float*)(lds + SC_GL);
  LAS float* dnl = (LAS float*)(lds + SC_GL + 256);
  const bool cmp = wave < 4;
  const int ctid = tid & 255;
  f32x4 accS[8][2];
#pragma unroll
  for (int kt = 0; kt < 8; ++kt) { accS[kt][0] = (f32x4){0.f, 0.f, 0.f, 0.f}; accS[kt][1] = (f32x4){0.f, 0.f, 0.f, 0.f}; }
  u32x2 ut[4][2];
  u32x4 stA[14], stB[14]; u32x4 dzr[4];
  const bf16_t* dzbase = P + ((size_t)b * LPAD + (ctid >> 2)) * NPROJ + 6144 + h * 128 + 32 * (ctid & 3);
#define SC_ITEM(n) (a.ws + WS_PREP + (size_t)(bh * NCH + (n)) * PREP_ITEM)
#define SC_LOADU(n) do { const unsigned char* ib_ = SC_ITEM(n); _Pragma("unroll") for (int ct_ = 0; ct_ < 4; ++ct_) _Pragma("unroll") for (int vt_ = 0; vt_ < 2; ++vt_) \
    ut[ct_][vt_] = *(const u32x2*)(ib_ + 49152 + (size_t)((((wave * 4 + ct_) * 2 + vt_) * 64) + lane) * 8); } while (0)
#define SC_LOADT(st, n) do { const unsigned char* ib_ = SC_ITEM(n); _Pragma("unroll") for (int i_ = 0; i_ < 4; ++i_) { \
    st[i_] = *(const u32x4*)(ib_ + (size_t)(ctid + 256 * i_) * 16); st[4 + i_] = *(const u32x4*)(ib_ + 16384 + (size_t)(ctid + 256 * i_) * 16); st[8 + i_] = *(const u32x4*)(ib_ + 32768 + (size_t)(ctid + 256 * i_) * 16); } \
    st[12] = *(const u32x4*)(ib_ + 65536 + (size_t)ctid * 16); st[13] = *(const u32x4*)(ib_ + 65536 + (size_t)(ctid + 256) * 16); } while (0)
#define SC_LOADDZ(n) do { _Pragma("unroll") for (int i_ = 0; i_ < 4; ++i_) dzr[i_] = *(const u32x4*)(dzbase + (size_t)(n) * 64 * NPROJ + 8 * i_); } while (0)
#define SC_STORET(st) do { _Pragma("unroll") for (int i_ = 0; i_ < 4; ++i_) { const int q_ = ctid + 256 * i_; \
    *(LAS u32x4*)(lds + SC_W + (q_ >> 4) * 272 + (q_ & 15) * 16) = st[i_]; *(LAS u32x4*)(lds + SC_QD + (q_ >> 4) * 272 + (q_ & 15) * 16) = st[4 + i_]; \
    *(LAS u32x4*)(lds + SC_KDT + (q_ >> 3) * 144 + (q_ & 7) * 16) = st[8 + i_]; } \
    *(LAS u32x4*)(lds + SC_QK + (ctid >> 3) * 144 + (ctid & 7) * 16) = st[12]; *(LAS u32x4*)(lds + SC_QK + ((ctid + 256) >> 3) * 144 + (ctid & 7) * 16) = st[13]; } while (0)
#define SC_NORM(n, ZQ) do { const int c_ = ctid >> 2, sg_ = ctid & 3; const LAS float* ob_ = (const LAS float*)(lds + SC_O + ((n) & 1) * SC_OSZ) + c_ * 132 + 32 * sg_; \
    float o_[32]; float ss_ = 0.f; \
    _Pragma("unroll") for (int q_ = 0; q_ < 8; ++q_) { const f32x4 v_ = *(const LAS f32x4*)(ob_ + 4 * q_); o_[4 * q_] = v_[0]; o_[4 * q_ + 1] = v_[1]; o_[4 * q_ + 2] = v_[2]; o_[4 * q_ + 3] = v_[3]; } \
    _Pragma("unroll") for (int e_ = 0; e_ < 32; ++e_) ss_ += o_[e_] * o_[e_]; \
    ss_ += __shfl_xor(ss_, 1); ss_ += __shfl_xor(ss_, 2); \
    const float rstd_ = rsqrtf(ss_ * (1.f / 128.f) + 1e-6f); \
    bf16_t* dst_ = P + ((size_t)b * LPAD + (size_t)(n) * 64 + c_) * NPROJ + 1024 + h * 128 + 32 * sg_; \
    _Pragma("unroll") for (int i_ = 0; i_ < 4; ++i_) { float r_[8]; \
      _Pragma("unroll") for (int e_ = 0; e_ < 4; ++e_) { const float z0_ = bflo(ZQ[i_][e_]), z1_ = bfhi(ZQ[i_][e_]); \
        r_[2 * e_] = o_[8 * i_ + 2 * e_] * rstd_ * dnl[32 * sg_ + 8 * i_ + 2 * e_] * siluf(z0_); r_[2 * e_ + 1] = o_[8 * i_ + 2 * e_ + 1] * rstd_ * dnl[32 * sg_ + 8 * i_ + 2 * e_ + 1] * siluf(z1_); } \
      u32x4 w_; w_.x = cvt_pk_bf16(r_[0], r_[1]); w_.y = cvt_pk_bf16(r_[2], r_[3]); w_.z = cvt_pk_bf16(r_[4], r_[5]); w_.w = cvt_pk_bf16(r_[6], r_[7]); \
      *(u32x4*)(dst_ + 8 * i_) = w_; } } while (0)
  if (cmp) {
    SC_LOADU(0);
    SC_BAR();
    if (tid < NCH) gls[tid] = GL[bh * NCH + tid];
    SC_BAR();
    for (int n = 0; n < NCH; ++n) {
      const float gl = gls[n];
      f32x4 accV[4][2];
#pragma unroll
      for (int ct = 0; ct < 4; ++ct)
#pragma unroll
        for (int vt = 0; vt < 2; ++vt) accV[ct][vt] = (f32x4){bflo(ut[ct][vt].x), bfhi(ut[ct][vt].x), bflo(ut[ct][vt].y), bfhi(ut[ct][vt].y)};
      if (n + 1 < NCH) SC_LOADU(n + 1);
      bf16x8 Sf[4][2];
#pragma unroll
      for (int ks = 0; ks < 4; ++ks) { Sf[ks][0] = pack8(accS[2 * ks][0], accS[2 * ks + 1][0]); Sf[ks][1] = pack8(accS[2 * ks][1], accS[2 * ks + 1][1]); }
#define SC_FW(ct, ks) (*(const LAS bf16x8*)(lds + SC_W + (16 * (ct) + fr) * 272 + (32 * (ks) + 8 * g) * 2))
#define SC_FQ(ct, ks) (*(const LAS bf16x8*)(lds + SC_QD + (16 * (ct) + fr) * 272 + (32 * (ks) + 8 * g) * 2))
#define SC_FK(ct, ks) (*(const LAS bf16x8*)(lds + SC_QK + (16 * (ct) + fr) * 144 + (32 * (ks) + 8 * g) * 2))
#define SC_FD(kt, ks) (*(const LAS bf16x8*)(lds + SC_KDT + (16 * (kt) + fr) * 144 + (32 * (ks) + 8 * g) * 2))
      bf16x8 fa[8], fb[8];
      LAS float* ob = (LAS float*)(lds + SC_O + (n & 1) * SC_OSZ);
#pragma unroll
      for (int ks = 0; ks < 4; ++ks) { fa[ks] = SC_FW(0, ks); fa[4 + ks] = SC_FW(1, ks); }
#pragma unroll
      for (int ks = 0; ks < 4; ++ks) { fb[ks] = SC_FW(2, ks); fb[4 + ks] = SC_FW(3, ks); }
      __builtin_amdgcn_sched_barrier(0);
#pragma unroll
      for (int ks = 0; ks < 4; ++ks)
#pragma unroll
        for (int vt = 0; vt < 2; ++vt) {
          accV[0][vt] = __builtin_amdgcn_mfma_f32_16x16x32_bf16(fa[ks], Sf[ks][vt], accV[0][vt], 0, 0, 0);
          accV[1][vt] = __builtin_amdgcn_mfma_f32_16x16x32_bf16(fa[4 + ks], Sf[ks][vt], accV[1][vt], 0, 0, 0);
        }
      __builtin_amdgcn_sched_barrier(0);
#pragma unroll
      for (int ks = 0; ks < 4; ++ks) { fa[ks] = SC_FQ(0, ks); fa[4 + ks] = SC_FQ(1, ks); }
      __builtin_amdgcn_sched_barrier(0);
#pragma unroll
      for (int ks = 0; ks < 4; ++ks)
#pragma unroll
        for (int vt = 0; vt < 2; ++vt) {
          accV[2][vt] = __builtin_amdgcn_mfma_f32_16x16x32_bf16(fb[ks], Sf[ks][vt], accV[2][vt], 0, 0, 0);
          accV[3][vt] = __builtin_amdgcn_mfma_f32_16x16x32_bf16(fb[4 + ks], Sf[ks][vt], accV[3][vt], 0, 0, 0);
        }
      __builtin_amdgcn_sched_barrier(0);
      f32x4 ao[2][2];
      bf16x8 Vf[2][2];
      fb[0] = SC_FK(0, 0); fb[1] = SC_FK(0, 1); fb[2] = SC_FK(1, 0); fb[3] = SC_FK(1, 1);
      __builtin_amdgcn_sched_barrier(0);
#pragma unroll
      for (int c1 = 0; c1 < 2; ++c1) { ao[c1][0] = (f32x4){0.f, 0.f, 0.f, 0.f}; ao[c1][1] = (f32x4){0.f, 0.f, 0.f, 0.f}; }
#pragma unroll
      for (int ks = 0; ks < 4; ++ks)
#pragma unroll
        for (int vt = 0; vt < 2; ++vt) {
          ao[0][vt] = __builtin_amdgcn_mfma_f32_16x16x32_bf16(fa[ks], Sf[ks][vt], ao[0][vt], 0, 0, 0);
          ao[1][vt] = __builtin_amdgcn_mfma_f32_16x16x32_bf16(fa[4 + ks], Sf[ks][vt], ao[1][vt], 0, 0, 0);
        }
#pragma unroll
      for (int vt = 0; vt < 2; ++vt) { Vf[0][vt] = pack8(accV[0][vt], accV[1][vt]); Vf[1][vt] = pack8(accV[2][vt], accV[3][vt]); }
      __builtin_amdgcn_sched_barrier(0);
#pragma unroll
      for (int ks = 0; ks < 4; ++ks) { fa[ks] = SC_FQ(2, ks); fa[4 + ks] = SC_FQ(3, ks); }
      __builtin_amdgcn_sched_barrier(0);
#pragma unroll
      for (int ks = 0; ks < 2; ++ks)
#pragma unroll
        for (int vt = 0; vt < 2; ++vt) {
          ao[0][vt] = __builtin_amdgcn_mfma_f32_16x16x32_bf16(fb[ks], Vf[ks][vt], ao[0][vt], 0, 0, 0);
          ao[1][vt] = __builtin_amdgcn_mfma_f32_16x16x32_bf16(fb[2 + ks], Vf[ks][vt], ao[1][vt], 0, 0, 0);
        }
      __builtin_amdgcn_sched_barrier(0);
      fb[4] = SC_FK(2, 0); fb[5] = SC_FK(2, 1); fb[6] = SC_FK(3, 0); fb[7] = SC_FK(3, 1);
#pragma unroll
      for (int c1 = 0; c1 < 2; ++c1)
#pragma unroll
        for (int vt = 0; vt < 2; ++vt)
#pragma unroll
          for (int rg = 0; rg < 4; ++rg) ob[(16 * c1 + 4 * g + rg) * 132 + 32 * wave + 16 * vt + fr] = ao[c1][vt][rg];
      __builtin_amdgcn_sched_barrier(0);
#pragma unroll
      for (int c1 = 0; c1 < 2; ++c1) { ao[c1][0] = (f32x4){0.f, 0.f, 0.f, 0.f}; ao[c1][1] = (f32x4){0.f, 0.f, 0.f, 0.f}; }
#pragma unroll
      for (int ks = 0; ks < 4; ++ks)
#pragma unroll
        for (int vt = 0; vt < 2; ++vt) {
          ao[0][vt] = __builtin_amdgcn_mfma_f32_16x16x32_bf16(fa[ks], Sf[ks][vt], ao[0][vt], 0, 0, 0);
          ao[1][vt] = __builtin_amdgcn_mfma_f32_16x16x32_bf16(fa[4 + ks], Sf[ks][vt], ao[1][vt], 0, 0, 0);
        }
      __builtin_amdgcn_sched_barrier(0);
#pragma unroll
      for (int k4 = 0; k4 < 4; ++k4) { fa[2 * k4] = SC_FD(k4, 0); fa[2 * k4 + 1] = SC_FD(k4, 1); }
      __builtin_amdgcn_sched_barrier(0);
#pragma unroll
      for (int ks = 0; ks < 2; ++ks)
#pragma unroll
        for (int vt = 0; vt < 2; ++vt) {
          ao[0][vt] = __builtin_amdgcn_mfma_f32_16x16x32_bf16(fb[4 + ks], Vf[ks][vt], ao[0][vt], 0, 0, 0);
          ao[1][vt] = __builtin_amdgcn_mfma_f32_16x16x32_bf16(fb[6 + ks], Vf[ks][vt], ao[1][vt], 0, 0, 0);
        }
      __builtin_amdgcn_sched_barrier(0);
#pragma unroll
      for (int k4 = 0; k4 < 4; ++k4) { fb[2 * k4] = SC_FD(4 + k4, 0); fb[2 * k4 + 1] = SC_FD(4 + k4, 1); }
#pragma unroll
      for (int c1 = 0; c1 < 2; ++c1)
#pragma unroll
        for (int vt = 0; vt < 2; ++vt)
#pragma unroll
          for (int rg = 0; rg < 4; ++rg) ob[(32 + 16 * c1 + 4 * g + rg) * 132 + 32 * wave + 16 * vt + fr] = ao[c1][vt][rg];
#pragma unroll
      for (int kt = 0; kt < 8; ++kt) { accS[kt][0] = accS[kt][0] * gl; accS[kt][1] = accS[kt][1] * gl; }
      __builtin_amdgcn_sched_barrier(0);
#pragma unroll
      for (int ks = 0; ks < 2; ++ks)
#pragma unroll
        for (int k4 = 0; k4 < 4; ++k4)
#pragma unroll
          for (int vt = 0; vt < 2; ++vt) accS[k4][vt] = __builtin_amdgcn_mfma_f32_16x16x32_bf16(fa[2 * k4 + ks], Vf[ks][vt], accS[k4][vt], 0, 0, 0);
      __builtin_amdgcn_sched_barrier(0);
#pragma unroll
      for (int ks = 0; ks < 2; ++ks)
#pragma unroll
        for (int k4 = 0; k4 < 4; ++k4)
#pragma unroll
          for (int vt = 0; vt < 2; ++vt) accS[4 + k4][vt] = __builtin_amdgcn_mfma_f32_16x16x32_bf16(fb[2 * k4 + ks], Vf[ks][vt], accS[4 + k4][vt], 0, 0, 0);
#undef SC_FW
#undef SC_FQ
#undef SC_FK
#undef SC_FD
      SC_BAR();
      SC_BAR();
    }
    SC_BAR();
  } else {
    SC_LOADT(stA, 0);
    SC_BAR();
    if (ctid < 128) dnl[ctid] = dnw[ctid];
    SC_STORET(stA);
    SC_LOADT(stB, 1);
    SC_BAR();
    for (int n = 0; n < NCH; n += 2) {
      {
        u32x4 zc[4];
#pragma unroll
        for (int i = 0; i < 4; ++i) zc[i] = dzr[i];
        SC_LOADDZ(n);
        if (n + 2 == NCH - 1) {
          unsigned* fl = (unsigned*)(a.ws + WS_CNT + 2048) + 16 * bh; unsigned sp = 0;
          while (__hip_atomic_load(fl, __ATOMIC_RELAXED, __HIP_MEMORY_SCOPE_AGENT) == 0u) { __builtin_amdgcn_s_sleep(2); if (++sp > (1u << 22)) break; }
          __builtin_amdgcn_fence(__ATOMIC_ACQUIRE, "agent");
          asm volatile("s_waitcnt vmcnt(0)" ::: "memory");
          if (ctid == 0) gls[NCH - 1] = __hip_atomic_load((const float*)(a.ws + WS_GL + 65536) + 32 * bh, __ATOMIC_RELAXED, __HIP_MEMORY_SCOPE_AGENT);
        }
        if (n + 2 < NCH) SC_LOADT(stA, n + 2);
        if (n >= 1) SC_NORM(n - 1, zc);
        SC_BAR();
        if (n + 1 < NCH) SC_STORET(stB);
        SC_BAR();
      }
      if (n + 1 < NCH) {
        u32x4 zc[4];
#pragma unroll
        for (int i = 0; i < 4; ++i) zc[i] = dzr[i];
        SC_LOADDZ(n + 1);
        if (n + 3 < NCH) SC_LOADT(stB, n + 3);
        SC_NORM(n, zc);
        SC_BAR();
        if (n + 2 < NCH) SC_STORET(stA);
        SC_BAR();
      }
    }
    SC_NORM(NCH - 1, dzr);
    SC_BAR();
  }
#undef SC_ITEM
#undef SC_LOADU
#undef SC_LOADT
#undef SC_LOADDZ
#undef SC_STORET
#undef SC_NORM
#undef SC_BAR
  __syncthreads();
}

constexpr int AT_K1 = 0, AT_K2 = 9216, AT_V = 18432, AT_BUF = 34816, AT_O = 2 * AT_BUF;
__device__ __forceinline__ unsigned voff_b(unsigned row, unsigned ch) { return 256u * row + 16u * (ch ^ (((row & 3) << 2) | ((row >> 2) & 3))); }
__device__ __forceinline__ s16x4 tr_read(LAS unsigned char* p) { return __builtin_amdgcn_ds_read_tr16_b64_v4i16((LAS s16x4*)p); }
__device__ __forceinline__ float xsw16_max(float x) { auto r = __builtin_amdgcn_permlane16_swap(__float_as_uint(x), __float_as_uint(x), false, false); return fmaxf(__uint_as_float(r[0]), __uint_as_float(r[1])); }
__device__ __forceinline__ float xsw32_max(float x) { auto r = __builtin_amdgcn_permlane32_swap(__float_as_uint(x), __float_as_uint(x), false, false); return fmaxf(__uint_as_float(r[0]), __uint_as_float(r[1])); }
__device__ __forceinline__ float xsw16_sum(float x) { auto r = __builtin_amdgcn_permlane16_swap(__float_as_uint(x), __float_as_uint(x), false, false); return __uint_as_float(r[0]) + __uint_as_float(r[1]); }
__device__ __forceinline__ float xsw32_sum(float x) { auto r = __builtin_amdgcn_permlane32_swap(__float_as_uint(x), __float_as_uint(x), false, false); return __uint_as_float(r[0]) + __uint_as_float(r[1]); }
__device__ __forceinline__ void attn_item(const KArgs& a, LAS unsigned char* lds, int bh, int p, float lam) {
  const int tid = threadIdx.x, lane = fresh_lane(), wave = __builtin_amdgcn_readfirstlane(tid >> 6), fr = lane & 15, g = lane >> 4;
  const int b = bh >> 3, h = bh & 7, comp = wave >> 2, wq = wave & 3;
  const int cmine = 2 * p + (wq >> 1);
  const bool act = cmine < NCH;
  const int clast = (2 * p + 1 < NCH) ? 2 * p + 1 : NCH - 1;
  const bf16_t* QR = (const bf16_t*)(a.ws + WS_QR); const bf16_t* KR = (const bf16_t*)(a.ws + WS_KR);
  bf16_t* P = (bf16_t*)(a.ws + WS_P);
  const size_t rb = (size_t)b * LPAD;
  const size_t qrow0 = rb + (size_t)128 * p + 32 * wq + fr;
  bf16x8 Qf[2][2];
#pragma unroll
  for (int qt = 0; qt < 2; ++qt)
#pragma unroll
    for (int ks = 0; ks < 2; ++ks) Qf[qt][ks] = act ? *(const bf16x8*)(QR + (qrow0 + 16 * qt) * 1024 + h * 128 + comp * 64 + 32 * ks + 8 * g) : (bf16x8){0, 0, 0, 0, 0, 0, 0, 0};
  f32x4 accO[2][8];
#pragma unroll
  for (int qt = 0; qt < 2; ++qt)
#pragma unroll
    for (int et = 0; et < 8; ++et) accO[qt][et] = (f32x4){0.f, 0.f, 0.f, 0.f};
  float m[2] = {-INFINITY, -INFINITY}, lsum[2] = {0.f, 0.f};
  unsigned vaddr[8];
  { const unsigned q4 = (unsigned)fr >> 2, p4 = (unsigned)fr & 3, row0 = 4u * g + q4;
#pragma unroll
    for (int et = 0; et < 8; ++et) vaddr[et] = AT_V + voff_b(row0, 2u * et + (p4 >> 1)) + 8u * (p4 & 1); }
  u32x4 sk1, sk2, sv0, sv1;
  const int krow = tid >> 3, kch = tid & 7;
  const int vrow0 = tid >> 4, vch = tid & 15;
  const bf16_t* kp = KR + (rb + krow) * 1024 + h * 128 + kch * 8;
  const bf16_t* vp = P + (rb + vrow0) * NPROJ + 2048 + h * 128 + vch * 8;
#define AT_LOAD(kt) do { sk1 = *(const u32x4*)kp; sk2 = *(const u32x4*)(kp + 64); sv0 = *(const u32x4*)vp; sv1 = *(const u32x4*)(vp + (size_t)32 * NPROJ); \
    kp += 64 * 1024; vp += (size_t)64 * NPROJ; } while (0)
#define AT_STORE(bf) do { LAS unsigned char* l_ = lds + (bf) * AT_BUF; *(LAS u32x4*)(l_ + AT_K1 + krow * 144 + kch * 16) = sk1; *(LAS u32x4*)(l_ + AT_K2 + krow * 144 + kch * 16) = sk2; \
    *(LAS u32x4*)(l_ + AT_V + voff_b(vrow0, vch)) = sv0; *(LAS u32x4*)(l_ + AT_V + voff_b(vrow0 + 32, vch)) = sv1; } while (0)
  AT_LOAD(0);
  __syncthreads();
  AT_STORE(0);
  __syncthreads();
  for (int kt = 0; kt <= clast; ++kt) {
    LAS unsigned char* lb = lds + (kt & 1) * AT_BUF;
    LAS unsigned char* kbase = lb + (comp ? AT_K2 : AT_K1);
    if (kt < clast) AT_LOAD(kt + 1);
    if (act && kt <= cmine) {
      bf16x8 Pf[2][2];
      {
        f32x4 s[2][4];
        bf16x8 kf[4][2];
#pragma unroll
        for (int nt = 0; nt < 4; ++nt)
#pragma unroll
          for (int ks = 0; ks < 2; ++ks) kf[nt][ks] = *(const LAS bf16x8*)(kbase + (16 * nt + fr) * 144 + (32 * ks + 8 * g) * 2);
        __builtin_amdgcn_sched_barrier(0);
        __builtin_amdgcn_s_setprio(1);
#pragma unroll
        for (int nt = 0; nt < 4; ++nt)
#pragma unroll
          for (int qt = 0; qt < 2; ++qt) s[qt][nt] = __builtin_amdgcn_mfma_f32_16x16x32_bf16(kf[nt][0], Qf[qt][0], (f32x4){0.f, 0.f, 0.f, 0.f}, 0, 0, 0);
#pragma unroll
        for (int nt = 0; nt < 4; ++nt)
#pragma unroll
          for (int qt = 0; qt < 2; ++qt) s[qt][nt] = __builtin_amdgcn_mfma_f32_16x16x32_bf16(kf[nt][1], Qf[qt][1], s[qt][nt], 0, 0, 0);
        __builtin_amdgcn_s_setprio(0);
        if (kt == 0) {
#pragma unroll
          for (int qt = 0; qt < 2; ++qt)
#pragma unroll
            for (int nt = 0; nt < 3; ++nt) s[qt][nt] = (f32x4){-INFINITY, -INFINITY, -INFINITY, -INFINITY};
        }
#pragma unroll
        for (int qt = 0; qt < 2; ++qt) {
          float mx = -INFINITY;
#pragma unroll
          for (int nt = 0; nt < 4; ++nt)
#pragma unroll
            for (int rg = 0; rg < 4; ++rg) mx = fmaxf(mx, s[qt][nt][rg]);
          mx = xsw16_max(mx); mx = xsw32_max(mx);
          const float mn = fmaxf(m[qt], mx);
          const float al = __builtin_amdgcn_exp2f(m[qt] - mn);
          const f32x4 mn4 = {mn, mn, mn, mn};
          f32x4 rs4 = {0.f, 0.f, 0.f, 0.f};
#pragma unroll
          for (int nt = 0; nt < 4; ++nt) { const f32x4 d = s[qt][nt] - mn4; f32x4 pv;
            pv[0] = __builtin_amdgcn_exp2f(d[0]); pv[1] = __builtin_amdgcn_exp2f(d[1]); pv[2] = __builtin_amdgcn_exp2f(d[2]); pv[3] = __builtin_amdgcn_exp2f(d[3]);
            s[qt][nt] = pv; rs4 = rs4 + pv; }
          float rs = (rs4[0] + rs4[1]) + (rs4[2] + rs4[3]);
          rs = xsw16_sum(rs); rs = xsw32_sum(rs);
          lsum[qt] = lsum[qt] * al + rs; m[qt] = mn;
#pragma unroll
          for (int et = 0; et < 8; ++et) accO[qt][et] = accO[qt][et] * al;
          Pf[qt][0] = pack8(s[qt][0], s[qt][1]); Pf[qt][1] = pack8(s[qt][2], s[qt][3]);
        }
      }
      {
        s16x4 va[2][8], vb[2][8];
#define AT_VLOAD(ks) do { _Pragma("unroll") for (int et_ = 0; et_ < 8; ++et_) { \
          va[ks][et_] = tr_read(lb + vaddr[et_] + (ks) * 8192); vb[ks][et_] = tr_read(lb + vaddr[et_] + (ks) * 8192 + 4096); } } while (0)
        AT_VLOAD(0);
        AT_VLOAD(1);
        __builtin_amdgcn_sched_barrier(0);
        __builtin_amdgcn_s_setprio(1);
#pragma unroll
        for (int ks = 0; ks < 2; ++ks)
#pragma unroll
          for (int et = 0; et < 8; ++et) {
            const bf16x8 vf = __builtin_shufflevector(va[ks][et], vb[ks][et], 0, 1, 2, 3, 4, 5, 6, 7);
            accO[0][et] = __builtin_amdgcn_mfma_f32_16x16x32_bf16(vf, Pf[0][ks], accO[0][et], 0, 0, 0);
            accO[1][et] = __builtin_amdgcn_mfma_f32_16x16x32_bf16(vf, Pf[1][ks], accO[1][et], 0, 0, 0);
          }
        __builtin_amdgcn_s_setprio(0);
#undef AT_VLOAD
      }
    }
    if (kt < clast) AT_STORE((kt + 1) & 1);
    __syncthreads();
  }
#pragma unroll
  for (int qt = 0; qt < 2; ++qt) {
    const float inv = act ? 1.f / lsum[qt] : 0.f;
#pragma unroll
    for (int et = 0; et < 8; ++et) accO[qt][et] = accO[qt][et] * inv;
  }
  if (comp == 1) {
#pragma unroll
    for (int qt = 0; qt < 2; ++qt) { LAS float* ob = (LAS float*)(lds + AT_O) + (wq * 32 + 16 * qt + fr) * 132;
#pragma unroll
      for (int et = 0; et < 8; ++et) *(LAS f32x4*)(ob + 16 * et + 4 * g) = accO[qt][et]; }
  }
  __syncthreads();
  if (comp == 0 && act) {
    const float* nw = a.in[10];
#pragma unroll
    for (int qt = 0; qt < 2; ++qt) {
      const LAS float* ob = (const LAS float*)(lds + AT_O) + (wq * 32 + 16 * qt + fr) * 132;
      float ss = 0.f;
#pragma unroll
      for (int et = 0; et < 8; ++et) { const f32x4 o2 = *(const LAS f32x4*)(ob + 16 * et + 4 * g); accO[qt][et] = accO[qt][et] - o2 * lam;
        ss += accO[qt][et][0] * accO[qt][et][0] + accO[qt][et][1] * accO[qt][et][1] + accO[qt][et][2] * accO[qt][et][2] + accO[qt][et][3] * accO[qt][et][3]; }
      ss = xsw16_sum(ss); ss = xsw32_sum(ss);
      const float rstd = rsqrtf(ss * (1.f / 128.f) + 1e-6f) * (1.f - LAM_INIT);
#pragma unroll
      for (int et = 0; et < 8; ++et) { const f32x4 w4 = *(const f32x4*)(nw + 16 * et + 4 * g);
        u32x2 w; w.x = cvt_pk_bf16(accO[qt][et][0] * rstd * w4[0], accO[qt][et][1] * rstd * w4[1]); w.y = cvt_pk_bf16(accO[qt][et][2] * rstd * w4[2], accO[qt][et][3] * rstd * w4[3]);
        *(u32x2*)(P + (qrow0 + 16 * qt) * NPROJ + h * 128 + 16 * et + 4 * g) = w; }
    }
  }
  __syncthreads();
#undef AT_LOAD
#undef AT_STORE
}

__device__ __forceinline__ void outproj_mini(const KArgs& a, int mu) {
  const int tid = threadIdx.x, ks = tid & 7, c8 = (tid >> 3) & 7, r8 = tid >> 6, c = 8 * mu + c8;
  const int b = r8 >> 1, t = 14 + (r8 & 1);
  const size_t row = (size_t)b * LPAD + FPAD + t;
  const bf16_t* arow = (const bf16_t*)(a.ws + WS_P) + row * NPROJ + 8 * ks;
  const bf16_t* wrow = (const bf16_t*)a.out + (size_t)c * DM + 8 * ks;
  float acc = 0.f;
#pragma unroll 8
  for (int k = 0; k < DM; k += 64) {
    const u32x4 av = *(const u32x4*)(arow + k), wv = *(const u32x4*)(wrow + k);
#pragma unroll
    for (int e = 0; e < 4; ++e) acc += bflo(av[e]) * bflo(wv[e]) + bfhi(av[e]) * bfhi(wv[e]);
  }
  acc += __shfl_xor(acc, 1); acc += __shfl_xor(acc, 2); acc += __shfl_xor(acc, 4);
  if (ks == 0) ((float*)(a.ws + WS_PRE1))[row * DM + c] = acc + ALPHA * a.in[1][(size_t)t * DM + c];
}

__device__ __forceinline__ void ln1_rows(const KArgs& a, int gw, int ngw, int lane) {
  const float* PRE = (const float*)(a.ws + WS_PRE1); bf16_t* H1B = (bf16_t*)(a.ws + WS_H1B);
  const float* gam = a.in[13]; const float* bet = a.in[14];
  f32x4 v[8];
  int r = gw;
#define LN1_T(rr) (((rr) % LPAD) - FPAD)
#define LN1_LOAD(dst, rr) do { const f32x4* xr_ = (const f32x4*)(PRE + (size_t)(rr) * DM) + lane; _Pragma("unroll") for (int i_ = 0; i_ < 8; ++i_) dst[i_] = xr_[64 * i_]; } while (0)
  if (r < R && LN1_T(r) >= 14) LN1_LOAD(v, r);
  while (r < R) {
    const int rn = r + ngw;
    const int b = r / LPAD, t = r - b * LPAD - FPAD;
    f32x4 w[8];
    if (rn < R && LN1_T(rn) >= 14) LN1_LOAD(w, rn);
    u32x2* orow = (u32x2*)(H1B + (size_t)r * DM);
    if (t < 14) {
#pragma unroll
      for (int i = 0; i < 8; ++i) orow[lane + 64 * i] = (u32x2){0u, 0u};
    } else {
      float s = 0.f;
#pragma unroll
      for (int i = 0; i < 8; ++i) s += (v[i][0] + v[i][1]) + (v[i][2] + v[i][3]);
      const float mean = wave_sum(s) * (1.f / DM); float s2 = 0.f;
#pragma unroll
      for (int i = 0; i < 8; ++i) { v[i] = v[i] - mean; s2 += (v[i][0] * v[i][0] + v[i][1] * v[i][1]) + (v[i][2] * v[i][2] + v[i][3] * v[i][3]); }
      const float rstd = rsqrtf(wave_sum(s2) * (1.f / DM) + 1e-5f);
      float* of = t >= NMETA ? a.out + ((size_t)b * SEQ + (t - NMETA)) * DM : nullptr;
#pragma unroll
      for (int i = 0; i < 8; ++i) {
        const f32x4 gg = *((const f32x4*)gam + lane + 64 * i), bb = *((const f32x4*)bet + lane + 64 * i);
        const f32x4 y = v[i] * rstd * gg + bb;
        orow[lane + 64 * i] = (u32x2){cvt_pk_bf16(y[0], y[1]), cvt_pk_bf16(y[2], y[3])};
        if (of) *((f32x4*)of + lane + 64 * i) = y;
      }
    }
#pragma unroll
    for (int i = 0; i < 8; ++i) v[i] = w[i];
    r = rn;
  }
#undef LN1_T
#undef LN1_LOAD
}
__device__ __forceinline__ void ln1_side_rows(const KArgs& a, int gw, int lane) {
  if (gw >= 8) return;
  const float* PRE = (const float*)(a.ws + WS_PRE1); bf16_t* H1B = (bf16_t*)(a.ws + WS_H1B);
  const float* gam = a.in[13]; const float* bet = a.in[14];
  const int r = (gw >> 1) * LPAD + FPAD + 14 + (gw & 1);
  const f32x4* xr = (const f32x4*)(PRE + (size_t)r * DM) + lane;
  u32x2* orow = (u32x2*)(H1B + (size_t)r * DM);
  f32x4 v[8]; float s = 0.f;
#pragma unroll
  for (int i = 0; i < 8; ++i) { v[i] = xr[64 * i]; s += (v[i][0] + v[i][1]) + (v[i][2] + v[i][3]); }
  const float mean = wave_sum(s) * (1.f / DM); float s2 = 0.f;
#pragma unroll
  for (int i = 0; i < 8; ++i) { v[i] = v[i] - mean; s2 += (v[i][0] * v[i][0] + v[i][1] * v[i][1]) + (v[i][2] * v[i][2] + v[i][3] * v[i][3]); }
  const float rstd = rsqrtf(wave_sum(s2) * (1.f / DM) + 1e-5f);
#pragma unroll
  for (int i = 0; i < 8; ++i) {
    const f32x4 gg = *((const f32x4*)gam + lane + 64 * i), bb = *((const f32x4*)bet + lane + 64 * i);
    const f32x4 y = v[i] * rstd * gg + bb;
    orow[lane + 64 * i] = (u32x2){cvt_pk_bf16(y[0], y[1]), cvt_pk_bf16(y[2], y[3])};
  }
}
__device__ __forceinline__ void ln2_rows(const KArgs& a, int gw, int ngw, int lane) {
  const float* gam = a.in[20]; const float* bet = a.in[21];
  f32x4 v[8];
  int r = gw;
  if (r < NB * SEQ) { const f32x4* xr = (const f32x4*)(a.out + (size_t)r * DM) + lane;
#pragma unroll
    for (int i = 0; i < 8; ++i) v[i] = xr[64 * i]; }
  while (r < NB * SEQ) {
    const int rn = r + ngw;
    f32x4 w[8];
    if (rn < NB * SEQ) { const f32x4* xn = (const f32x4*)(a.out + (size_t)rn * DM) + lane;
#pragma unroll
      for (int i = 0; i < 8; ++i) w[i] = xn[64 * i]; }
    f32x4* xr = (f32x4*)(a.out + (size_t)r * DM) + lane;
    float s = 0.f;
#pragma unroll
    for (int i = 0; i < 8; ++i) s += (v[i][0] + v[i][1]) + (v[i][2] + v[i][3]);
    const float mean = wave_sum(s) * (1.f / DM); float s2 = 0.f;
#pragma unroll
    for (int i = 0; i < 8; ++i) { v[i] = v[i] - mean; s2 += (v[i][0] * v[i][0] + v[i][1] * v[i][1]) + (v[i][2] * v[i][2] + v[i][3] * v[i][3]); }
    const float rstd = rsqrtf(wave_sum(s2) * (1.f / DM) + 1e-5f);
#pragma unroll
    for (int i = 0; i < 8; ++i) {
      const f32x4 gg = *((const f32x4*)gam + lane + 64 * i), bb = *((const f32x4*)bet + lane + 64 * i);
      xr[64 * i] = v[i] * rstd * gg + bb;
    }
#pragma unroll
    for (int i = 0; i < 8; ++i) v[i] = w[i];
    r = rn;
  }
}

#define XB_TMO      128
#define XB_XCNT(j)  (256  + 64 * (j))
#define XB_XSUB(j)  (1280 + 64 * (j))
#define XB_XGEN(j)  (2304 + 64 * (j))
#define XB_TOP      3328
#define XB_TOPGEN   3392
#define XCD_BAR_WORDS 3456
#define XB_SPIN_CAP (1u << 18)
__device__ __forceinline__ unsigned xb_ld(unsigned* p)              { return __hip_atomic_load(p, __ATOMIC_RELAXED, __HIP_MEMORY_SCOPE_AGENT); }
__device__ __forceinline__ unsigned xb_add(unsigned* p, unsigned v) { return __hip_atomic_fetch_add(p, v, __ATOMIC_RELAXED, __HIP_MEMORY_SCOPE_AGENT); }
__device__ __forceinline__ unsigned xb_xcc_id() { return (unsigned)__builtin_amdgcn_s_getreg((3 << 11) | 20) & 0xFu; }
#define XB_SPIN(cond, bar) do { unsigned _sp = 0; while (cond) { __builtin_amdgcn_s_sleep(1); \
    if ((++_sp & 255u) == 0u) { if (xb_ld(&(bar)[XB_TMO])) break; if (_sp > XB_SPIN_CAP) { atomicAdd(&(bar)[XB_TMO], 1u); break; } } } } while (0)
struct XcdBarrier { unsigned* bar; unsigned x; volatile LAS unsigned* st; };
__device__ __forceinline__ XcdBarrier xcd_barrier_post(unsigned* bar, volatile LAS unsigned* st) {
  XcdBarrier b; b.bar = bar; b.x = xb_xcc_id(); b.st = st;
  if (threadIdx.x == 0) (void)xb_add(&bar[XB_XCNT(b.x)], 1u);
  return b;
}
__device__ __forceinline__ void xcd_barrier_complete(unsigned* bar, unsigned x, unsigned& nloc, unsigned& nx) {
  const unsigned G = gridDim.x;
  unsigned sum, cnt, mine, sp = 0u;
  for (;;) {
    sum = 0u; cnt = 0u; mine = 0u;
#pragma unroll
    for (unsigned j = 0; j < 16; ++j) { const unsigned c = xb_ld(&bar[XB_XCNT(j)]); sum += c; cnt += (c > 0u) ? 1u : 0u; mine = (j == x) ? c : mine; }
    if (sum == G) break;
    __builtin_amdgcn_s_sleep(1);
    if ((++sp & 255u) == 0u) { if (xb_ld(&bar[XB_TMO])) break; if (sp > XB_SPIN_CAP) { atomicAdd(&bar[XB_TMO], 1u); break; } }
  }
  nloc = mine > 0u ? mine : 1u; nx = cnt > 0u ? cnt : 1u;
}
__device__ __forceinline__ void xcd_barrier(const XcdBarrier& b) {
  asm volatile("s_waitcnt vmcnt(0)" ::: "memory");
  __syncthreads();
  if (threadIdx.x == 0) {
    unsigned* bar = b.bar;
    __builtin_amdgcn_s_waitcnt(0);
    unsigned nloc = b.st[0], nx = b.st[1];
    if (nloc == 0u) { xcd_barrier_complete(bar, b.x, nloc, nx); b.st[0] = nloc; b.st[1] = nx; }
    const unsigned old = xb_add(&bar[XB_XSUB(b.x)], 1u);
    const unsigned gen = old / nloc;
    if (old + 1u == (gen + 1u) * nloc) {
      __builtin_amdgcn_fence(__ATOMIC_RELEASE, "agent");
      asm volatile("s_waitcnt vmcnt(0)" ::: "memory");
      const unsigned og = xb_add(&bar[XB_TOP], 1u);
      const unsigned tg = og / nx;
      if (og + 1u == (tg + 1u) * nx) xb_add(&bar[XB_TOPGEN], 1u);
      else XB_SPIN(xb_ld(&bar[XB_TOPGEN]) == tg, bar);
      __builtin_amdgcn_fence(__ATOMIC_ACQUIRE, "agent");
      xb_add(&bar[XB_XGEN(b.x)], 1u);
      asm volatile("s_waitcnt vmcnt(0)" ::: "memory");
    } else {
      XB_SPIN(xb_ld(&bar[XB_XGEN(b.x)]) == gen, bar);
      __builtin_amdgcn_fence(__ATOMIC_ACQUIRE, "agent");
      asm volatile("s_waitcnt vmcnt(0)" ::: "memory");
    }
  }
  __syncthreads();
}

__global__ void __launch_bounds__(NTHR, 2) mega(KArgs a) {
  extern __shared__ __attribute__((aligned(16))) unsigned char lds_raw[];
  LAS unsigned char* lds = (LAS unsigned char*)lds_raw;
  const int tid = threadIdx.x, wave = __builtin_amdgcn_readfirstlane(tid >> 6);
  const int G = gridDim.x, gw = blockIdx.x * NWAVE + wave, ngw = G * NWAVE;
  const int lo = a.ph_lo, hi = a.ph_hi;
#define IN(k) (lo <= (k) && (k) < hi)
#define SEAM0() do { if (IN(0) && IN(1)) xcd_barrier(xbar); } while (0)
#define SEAM(k) do { if (IN(k) && IN((k) + 1)) xcd_barrier(xbar); } while (0)
  volatile LAS unsigned* xst = (volatile LAS unsigned*)(lds + 147200);
  XcdBarrier xbar; xbar.bar = (unsigned*)(a.ws + WS_CNT + 16384); xbar.x = 0; xbar.st = xst;
  if (hi - lo > 1) {
    if (tid < 2) xst[tid] = 0u;
    __syncthreads();
    xbar = xcd_barrier_post((unsigned*)(a.ws + WS_CNT + 16384), xst);
  }
  if (a.ph_hi > 1000) cg::this_grid().sync();
  if (IN(0)) {
    p0_rows(a, lds, gw, ngw, fresh_lane());
    transpose_all(a.in[2], DM, INCOLS, NPROJ, (bf16_t*)(a.ws + WS_WINT), lds, gw, ngw, wave, fresh_lane());
  }
  SEAM0();
  if (IN(1)) {
    pg8::Gemm g{(const bf16_t*)(a.ws + WS_H0), (const bf16_t*)(a.ws + WS_WINT), DM, DM, 0};
    pg8::StaticOrder S; S.init(R / 256, NPROJ / 256, G, (int)blockIdx.x);
    pg8::EpiBf16 E{(bf16_t*)(a.ws + WS_P), NPROJ};
    pg8::gemm_phase<pg8::EpiBf16>(lds, g, S, E);
  }
  SEAM(1);
  if (IN(2)) {
    p2_rope(a, gw, ngw, fresh_lane());
    transpose_all(a.in[12], DM, DM, DM, (bf16_t*)a.out, lds, gw, ngw, wave, fresh_lane());
    __syncthreads();
#define PREP_ITEM_OF(L) ((((L) >> 5) * NCH) + ((L) & 31))
    if (wave == 0 && (int)blockIdx.x < 1024) prep_stepA(a, lds, PREP_ITEM_OF((int)blockIdx.x), 0, fresh_lane());
    __syncthreads();
    { int slot = 0;
      for (int L = blockIdx.x; L < 1024; L += G) { prep_item(a, lds, PREP_ITEM_OF(L), slot, L + G < 1024 ? PREP_ITEM_OF(L + G) : -1); slot ^= 1; } }
  }
  SEAM(2);
  if (IN(3)) {
    LAS int* qslot = (LAS int*)(lds + 147000);
    const float p1 = a.in[6][fresh_lane()] * a.in[7][fresh_lane()], p2 = a.in[8][fresh_lane()] * a.in[9][fresh_lane()];
    const float lam = expf(wave_sum(p1)) - expf(wave_sum(p2)) + LAM_INIT;
    if (blockIdx.x < NB * 8) scan_bh(a, lds, (int)blockIdx.x);
    else if (blockIdx.x < 2 * NB * 8) {
      const int pbh = (int)blockIdx.x - NB * 8, pit = pbh * NCH + (NCH - 1);
      if (wave == 0) prep_stepA(a, lds, pit, 0, fresh_lane());
      __syncthreads();
      prep_item(a, lds, pit, 0, -1);
      asm volatile("s_waitcnt vmcnt(0)" ::: "memory");
      __syncthreads();
      if (tid == 0) {
        const float glv = ((const float*)(a.ws + WS_GL))[pit];
        __builtin_amdgcn_fence(__ATOMIC_RELEASE, "agent");
        asm volatile("s_waitcnt vmcnt(0)" ::: "memory");
        __hip_atomic_store((float*)(a.ws + WS_GL + 65536) + 32 * pbh, glv, __ATOMIC_RELAXED, __HIP_MEMORY_SCOPE_AGENT);
        asm volatile("s_waitcnt vmcnt(0)" ::: "memory");
        __hip_atomic_store((unsigned*)(a.ws + WS_CNT + 2048) + 16 * pbh, 1u, __ATOMIC_RELAXED, __HIP_MEMORY_SCOPE_AGENT);
      }
    }
    unsigned* cnt = (unsigned*)(a.ws + WS_CNT);
    for (;;) {
      __syncthreads();
      if (tid == 0) *qslot = (int)atomicAdd(cnt, 1u);
      __syncthreads();
      const int q = *qslot;
      if (q >= NB * 8 * 17) break;
      attn_item(a, lds, q & 31, 16 - (q >> 5), lam);
    }
  }
  SEAM(3);
  if (IN(4)) {
    for (int mu = blockIdx.x; mu < 256; mu += G) outproj_mini(a, mu);
    pg8::Gemm g{(const bf16_t*)(a.ws + WS_P), (const bf16_t*)a.out, NPROJ, DM, 1};
    pg8::StaticOrder S; S.init(NB * SEQ / 256, DM / 256, G, (int)blockIdx.x);
    if (G == 256 && hi - lo > 1) {
      pg8::EpiOutProjLN E{a.in[0], a.out + 0, (bf16_t*)(a.ws + WS_H1B), a.in[13], a.in[14], (unsigned long long*)(a.ws + 3 * MiB + 524288), (unsigned*)(a.ws + WS_CNT + 4096) + 32, &xbar};
      pg8::gemm_phase<pg8::EpiOutProjLN>(lds, g, S, E);
      ln1_side_rows(a, gw, fresh_lane());
    } else {
      pg8::EpiOutProj E{(float*)(a.ws + WS_PRE1), a.in[0]};
      pg8::gemm_phase<pg8::EpiOutProj>(lds, g, S, E);
    }
    transpose_all(a.in[15], DM, DFF, DFF, (bf16_t*)(a.ws + WS_WG), lds, gw, ngw, wave, fresh_lane());
    transpose_all(a.in[16], DM, DFF, DFF, (bf16_t*)(a.ws + WS_WU), lds, gw, ngw, wave, fresh_lane());
  }
  SEAM(4);
  if (!(G == 256 && hi - lo > 1)) {
    if (IN(5)) ln1_rows(a, gw, ngw, fresh_lane());
    SEAM(5);
  }
  if (IN(6)) {
    pg8::Gemm g{(const bf16_t*)(a.ws + WS_H1B), (const bf16_t*)(a.ws + WS_WG), DM, DM, 0};
    pg8::StaticOrder S; S.init(R / 256, DFF / 256, G, (int)blockIdx.x);
    pg8::EpiBf16 E{(bf16_t*)(a.ws + WS_G), DFF};
    pg8::gemm_phase<pg8::EpiBf16>(lds, g, S, E);
  }
  SEAM(6);
  if (IN(7)) {
    pg8::Gemm g{(const bf16_t*)(a.ws + WS_H1B), (const bf16_t*)(a.ws + WS_WU), DM, DM, 0};
    pg8::StaticOrder S; S.init(R / 256, DFF / 256, G, (int)blockIdx.x);
    pg8::EpiUpAct E{(bf16_t*)(a.ws + WS_ACT), (const bf16_t*)(a.ws + WS_G), a.in[17], a.in[18]};
    pg8::gemm_phase<pg8::EpiUpAct>(lds, g, S, E);
    transpose_all(a.in[19], DFF, DM, DM, (bf16_t*)(a.ws + WS_WG), lds, gw, ngw, wave, fresh_lane());
  }
  SEAM(7);
  if (IN(8)) {
    pg8::Gemm g{(const bf16_t*)(a.ws + WS_ACT), (const bf16_t*)(a.ws + WS_WG), DFF, DFF, 1};
    pg8::StaticOrder S; S.init(NB * SEQ / 256, DM / 256, G, (int)blockIdx.x);
    if (G == 256) {
      pg8::EpiDownLN E{a.out, a.in[20], a.in[21], (unsigned long long*)(a.ws + 3 * MiB), (unsigned*)(a.ws + WS_CNT + 4096)};
      pg8::gemm_phase<pg8::EpiDownLN>(lds, g, S, E);
    } else {
      pg8::EpiDown E{a.out};
      pg8::gemm_phase<pg8::EpiDown>(lds, g, S, E);
    }
  }
  if (G != 256) {
    SEAM(8);
    if (IN(9)) ln2_rows(a, gw, ngw, fresh_lane());
  }
}


#ifdef DBG_STAGE
__global__ void dbg_dump(const void* buf, size_t n, int isbf, size_t row_elems, size_t col_lo, size_t col_hi, float* out, size_t nout) {
  for (size_t i = (size_t)blockIdx.x * blockDim.x + threadIdx.x; i < nout; i += (size_t)gridDim.x * blockDim.x) {
    float flag = 0.f;
    for (size_t j = i; j < n; j += nout) {
      const size_t c = j % row_elems;
      if (c < col_lo || c >= col_hi) continue;
      const float v = isbf ? bf2f(((const bf16_t*)buf)[j]) : ((const float*)buf)[j];
      if (!(v == v) || fabsf(v) > 1e30f) flag = 1000.f;
    }
    out[i] = flag;
  }
}
#endif
extern "C" void kernel_launch(void* const* d_in, const int* in_sizes, int n_in, void* d_out, int out_size, void* d_ws, size_t ws_size, hipStream_t stream) {
  static int grid = 0;
  if (grid == 0) {
    int dev = 0, cus = 0, per_cu = 0;
    (void)hipGetDevice(&dev);
    (void)hipDeviceGetAttribute(&cus, hipDeviceAttributeMultiprocessorCount, dev);
    (void)hipFuncSetAttribute((const void*)mega, hipFuncAttributeMaxDynamicSharedMemorySize, LDS_BYTES);
    (void)hipOccupancyMaxActiveBlocksPerMultiprocessor(&per_cu, (const void*)mega, NTHR, LDS_BYTES);
    if (per_cu < 1) per_cu = 1;
    grid = cus * 1;
    if (n_in != 22 || ws_size < WS_END) { fprintf(stderr, "kernel_launch: bad sizes n_in %d ws %zu\n", n_in, ws_size); grid = -1; }
  }
  if (grid < 0) return;
  (void)hipMemsetAsync((char*)d_ws + WS_CNT, 0, 32768, stream);
  KArgs a{};
  for (int i = 0; i < 22; ++i) a.in[i] = (const float*)d_in[i];
  a.out = (float*)d_out; a.ws = (unsigned char*)d_ws; a.ph_lo = 0; a.ph_hi = 10;
#ifndef MK_SPLIT
#define MK_SPLIT 0
#endif
  hipError_t e = hipSuccess;
#if MK_SPLIT
#ifdef DBG_STAGE
  const int nph = DBG_STAGE + 1;
#else
  const int nph = 10;
#endif
  for (int ph = 0; ph < nph; ++ph) { a.ph_lo = ph; a.ph_hi = ph + 1; hipLaunchKernelGGL(mega, dim3(grid), dim3(NTHR), LDS_BYTES, stream, a); }
#ifdef DBG_STAGE
  { unsigned char* w = (unsigned char*)d_ws; float* o = (float*)d_out; const size_t no = (size_t)out_size;
    if (DBG_STAGE == 0) hipLaunchKernelGGL(dbg_dump, dim3(2048), dim3(256), 0, stream, (const void*)(w + WS_H0), (size_t)R * DM, 1, (size_t)DM, (size_t)0, (size_t)DM, o, no);
    if (DBG_STAGE == 1) hipLaunchKernelGGL(dbg_dump, dim3(2048), dim3(256), 0, stream, (const void*)(w + WS_P), (size_t)R * NPROJ, 1, (size_t)NPROJ, (size_t)0, (size_t)NPROJ, o, no);
    if (DBG_STAGE == 2) hipLaunchKernelGGL(dbg_dump, dim3(2048), dim3(256), 0, stream, (const void*)(w + WS_QR), (size_t)(WS_WOUT - WS_QR) / 2 + (size_t)DM * DM, 1, (size_t)64, (size_t)0, (size_t)64, o, no);
    if (DBG_STAGE == 3) hipLaunchKernelGGL(dbg_dump, dim3(2048), dim3(256), 0, stream, (const void*)(w + WS_P), (size_t)R * NPROJ, 1, (size_t)NPROJ, (size_t)DBG_CLO, (size_t)DBG_CHI, o, no);
    if (DBG_STAGE == 4) hipLaunchKernelGGL(dbg_dump, dim3(2048), dim3(256), 0, stream, (const void*)(w + WS_PRE1), (size_t)R * DM, 0, (size_t)DM, (size_t)0, (size_t)DM, o, no);
    if (DBG_STAGE == 5) hipLaunchKernelGGL(dbg_dump, dim3(2048), dim3(256), 0, stream, (const void*)(w + WS_H1B), (size_t)R * DM, 1, (size_t)DM, (size_t)0, (size_t)DM, o, no);
    if (DBG_STAGE == 6) hipLaunchKernelGGL(dbg_dump, dim3(2048), dim3(256), 0, stream, (const void*)(w + WS_G), (size_t)R * DFF, 1, (size_t)DFF, (size_t)0, (size_t)DFF, o, no);
    if (DBG_STAGE == 7) hipLaunchKernelGGL(dbg_dump, dim3(2048), dim3(256), 0, stream, (const void*)(w + WS_ACT), (size_t)R * DFF, 1, (size_t)DFF, (size_t)0, (size_t)DFF, o, no);
  }
#endif
  e = hipGetLastError();
#else
  void* args[] = {&a};
  e = hipLaunchCooperativeKernel((void*)mega, dim3(grid), dim3(NTHR), args, LDS_BYTES, stream);
#endif
  if (e != hipSuccess) fprintf(stderr, "cooperative launch failed: %s (grid %d)\n", hipGetErrorString(e), grid);
}
```

```cpp
#include <hip/hip_runtime.h>
#include <hip/hip_cooperative_groups.h>
#include <cstdio>
#define DBG_CLO 0
#define DBG_CHI 2048
namespace cg = cooperative_groups;

#define LAS __attribute__((address_space(3)))
typedef unsigned short bf16_t;
typedef short bf16x8 __attribute__((ext_vector_type(8)));
typedef short s16x4 __attribute__((ext_vector_type(4)));
typedef float f32x4 __attribute__((ext_vector_type(4)));
typedef float f32x2 __attribute__((ext_vector_type(2)));
typedef unsigned u32x4 __attribute__((ext_vector_type(4)));
typedef unsigned u32x2 __attribute__((ext_vector_type(2)));

constexpr int NB = 4, SEQ = 2048, NMETA = 16, LTOK = SEQ + NMETA, FPAD = 48, LPAD = LTOK + FPAD  , R = NB * LPAD  ;
constexpr int DM = 2048, NPROJ = 7168, INCOLS = 7184, DFF = 5632, NCH = LPAD / 64  ;
constexpr float ALPHA = 1.189207115002721f;
constexpr float LAM_INIT = 0.2f;
constexpr int NTHR = 512, NWAVE = 8;
constexpr int LDS_BYTES = 147456;

constexpr size_t MiB = 1u << 20;
constexpr size_t WS_BA = 0;
constexpr size_t WS_GL = 1 * MiB;
constexpr size_t WS_CNT = 2 * MiB;
constexpr size_t WS_P = 4 * MiB;
constexpr size_t WS_WINT = 120 * MiB;
constexpr size_t WS_H0 = 148 * MiB;
constexpr size_t WS_QR = 120 * MiB;
constexpr size_t WS_KR = WS_QR + (size_t)R * 1024 * 2;
constexpr size_t WS_PREP = 153 * MiB;
constexpr size_t PREP_ITEM = 73728;
constexpr size_t WS_WOUT = 228 * MiB;
constexpr size_t WS_PRE1 = 120 * MiB;
constexpr size_t WS_H1B = 186 * MiB;
constexpr size_t WS_G = 4 * MiB;
constexpr size_t WS_ACT = 95 * MiB;
constexpr size_t WS_WG = 219 * MiB;
constexpr size_t WS_WU = 241 * MiB;
constexpr size_t WS_END = 263 * MiB;
static_assert(WS_KR + (size_t)R * 1024 * 2 <= WS_PREP && WS_PREP + (size_t)NB * 8 * NCH * PREP_ITEM <= WS_WOUT, "ws map");
static_assert(WS_G + (size_t)R * DFF * 2 <= WS_ACT && WS_ACT + (size_t)R * DFF * 2 <= WS_H1B && WS_H1B + (size_t)R * DM * 2 <= WS_WG, "ws map 2");

typedef __bf16 bf16x2v __attribute__((ext_vector_type(2)));
__device__ __forceinline__ unsigned cvt_pk_bf16(float lo, float hi) { const f32x2 v = {lo, hi}; const bf16x2v b = __builtin_convertvector(v, bf16x2v); return __builtin_bit_cast(unsigned, b); }
__device__ __forceinline__ float bf2f(unsigned short b) { return __uint_as_float(((unsigned)b) << 16); }
__device__ __forceinline__ float bflo(unsigned w) { return __uint_as_float(w << 16); }
__device__ __forceinline__ float bfhi(unsigned w) { return __uint_as_float(w & 0xffff0000u); }
__device__ __forceinline__ bf16_t f2bf(float f) { return (bf16_t)(cvt_pk_bf16(f, 0.f) & 0xffffu); }
template <int CTRL> __device__ __forceinline__ float dpp_mov(float x) { return __uint_as_float((unsigned)__builtin_amdgcn_update_dpp(0, (int)__float_as_uint(x), CTRL, 0xF, 0xF, true)); }
__device__ __forceinline__ float wave_sum(float v) {
  v += dpp_mov<0xB1>(v);
  v += dpp_mov<0x4E>(v);
  v += dpp_mov<0x141>(v);
  v += dpp_mov<0x140>(v);
  { auto r = __builtin_amdgcn_permlane16_swap(__float_as_uint(v), __float_as_uint(v), false, false); v = __uint_as_float(r[0]) + __uint_as_float(r[1]); }
  { auto r = __builtin_amdgcn_permlane32_swap(__float_as_uint(v), __float_as_uint(v), false, false); v = __uint_as_float(r[0]) + __uint_as_float(r[1]); }
  return v;
}
__device__ __forceinline__ float siluf(float x) { return x * __builtin_amdgcn_rcpf(1.f + __expf(-x)); }
#define LDS_WAIT() asm volatile("s_waitcnt lgkmcnt(0)" ::: "memory")
#define LBAR() do { asm volatile("s_waitcnt lgkmcnt(0)" ::: "memory"); __builtin_amdgcn_s_barrier(); asm volatile("" ::: "memory"); } while (0)
__device__ __forceinline__ int fresh_lane() { int l; asm volatile("v_and_b32 %0, 63, %1" : "=v"(l) : "v"((int)threadIdx.x)); return l; }

struct KArgs { const float* in[22]; float* out; unsigned char* ws; int ph_lo, ph_hi; };

struct XcdBarrier;
__device__ __forceinline__ void xcd_barrier(const XcdBarrier& b);
namespace pg8 {
constexpr int BM = 256, BK = 64, HALF = 128, HTB = HALF * BK * 2, STAGE_BYTES = 8 * HTB, NXCD = 8, WGM = 8;
__host__ __device__ __forceinline__ int lds_byte(int r, int c) { const int st = (r >> 4) * 2 + (c >> 5), rr = r & 15, cc = c & 31, ob = rr * 64 + cc * 2; return st * 1024 + (ob ^ (((ob >> 9) & 1) << 5)); }
__host__ __device__ __forceinline__ void stage_rc(int b, int& Rr, int& C) { const int st = b / 1024, sb = b % 1024, swz = sb ^ (((sb >> 9) & 1) << 5); Rr = (st >> 1) * 16 + swz / 64; C = (st & 1) * 32 + (swz % 64) / 2; }
__host__ __device__ __forceinline__ int perm32(int rho) { const int n = rho >> 4, i = rho & 15; return 8 * (i >> 2) + 4 * n + (i & 3); }
struct Unit { int pm, pn; };
struct Gemm { const bf16_t* A; const bf16_t* Bt; int lda, K; int rowmap; };
__device__ __forceinline__ size_t a_row0(int rowmap, int pm) { return rowmap ? (size_t)((pm >> 3) * LPAD + 64 + (pm & 7) * 256) : (size_t)pm * 256; }
struct StaticOrder {
  int nM, nN, nwg, G, c;
  __device__ void init(int nM_, int nN_, int G_, int c_) { nM = nM_; nN = nN_; nwg = nM * nN; G = G_; c = c_; }
  __device__ bool next(int i, Unit& u) const {
    const long L = (long)i * G + c; if (L >= nwg) return false;
    int wgid = (int)L; { const int q = nwg / NXCD, r = nwg % NXCD, xcd = wgid % NXCD, off = wgid / NXCD; wgid = (xcd < r ? xcd * (q + 1) : r * (q + 1) + (xcd - r) * q) + off; }
    const int nig = WGM * nN, gid = wgid / nig, fm = gid * WGM, gsz = (nM - fm) < WGM ? (nM - fm) : WGM;
    u.pm = fm + ((wgid % nig) % gsz); u.pn = (wgid % nig) / gsz; return true;
  }
};

template <class Epi>
__device__ __forceinline__ void gemm_phase(LAS unsigned char* lds, const Gemm g, const StaticOrder& S, const Epi& E) {
  const int tid = threadIdx.x, wid = __builtin_amdgcn_readfirstlane(tid >> 6), lane = fresh_lane(), wr = wid >> 2, wc = wid & 3, fr = lane & 15, fq = lane >> 4;
  const int K = g.K, nt = K / BK, lda = g.lda;
  unsigned voffA[2], voffB[2];
#pragma unroll
  for (int i = 0; i < 2; ++i) { int Rr, C; stage_rc(tid * 16 + i * 8192, Rr, C); const int Rb = Epi::PERM ? ((Rr & ~31) + perm32(Rr & 31)) : Rr;
    voffA[i] = (unsigned)(Rr * lda + C) * 2u; voffB[i] = (unsigned)(Rb * K + C) * 2u; }
  const size_t kstep = (size_t)(BK * 2);
  const size_t hstepA = (size_t)HALF * lda * 2, hstepB = (size_t)HALF * K * 2;
  const unsigned ldsw = (unsigned)wid * 1024u;
  const int aoff = lds_byte(wr * 64 + fr, fq * 8), boff = lds_byte(wc * 32 + fr, fq * 8);
#define PG8_SA(b, h) (((b) * 2 + (h)) * HTB)
#define PG8_SB(b, h) ((4 + (b) * 2 + (h)) * HTB)
#define PG8_STAGE(bufoff, gbase, voff) do { _Pragma("unroll") for (int _i = 0; _i < 2; ++_i) \
    __builtin_amdgcn_global_load_lds((const unsigned*)((const char*)(gbase) + (voff)[_i]), (LAS unsigned*)(lds + (bufoff) + ldsw + _i * 8192), 16, 0, 0); } while (0)
#define PG8_LDA(dst, b, h) do { _Pragma("unroll") for (int m = 0; m < 4; ++m) _Pragma("unroll") for (int k = 0; k < 2; ++k) dst[m][k] = *(const LAS bf16x8*)(lds + PG8_SA(b, h) + aoff + m * 2048 + k * 1024); } while (0)
#define PG8_LDB(dst, b, h) do { _Pragma("unroll") for (int n = 0; n < 2; ++n) _Pragma("unroll") for (int k = 0; k < 2; ++k) dst[n][k] = *(const LAS bf16x8*)(lds + PG8_SB(b, h) + boff + n * 2048 + k * 1024); } while (0)
#define PG8_MMA(ai, bj, At, Bt) do { __builtin_amdgcn_s_setprio(1); _Pragma("unroll") for (int m = 0; m < 4; ++m) _Pragma("unroll") for (int n = 0; n < 2; ++n) _Pragma("unroll") for (int k = 0; k < 2; ++k) \
    acc[ai][bj][m][n] = __builtin_amdgcn_mfma_f32_16x16x32_bf16(Bt[n][k], At[m][k], acc[ai][bj][m][n], 0, 0, 0); __builtin_amdgcn_s_setprio(0); } while (0)
#define PG8_WAIT_V(n) asm volatile("s_waitcnt vmcnt(" #n ")" ::: "memory")
#define PG8_WAIT_L(n) asm volatile("s_waitcnt lgkmcnt(" #n ")" ::: "memory")
#define PG8_BAR __builtin_amdgcn_s_barrier()
#define PG8_SCHED __builtin_amdgcn_sched_barrier(0)
  Unit cur, nxt; int ui = 0;
  if (!S.next(0, cur)) return;
  f32x4 acc[2][2][4][2];
#pragma unroll
  for (int a = 0; a < 2; ++a)
#pragma unroll
    for (int b = 0; b < 2; ++b)
#pragma unroll
      for (int m = 0; m < 4; ++m)
#pragma unroll
        for (int n = 0; n < 2; ++n) acc[a][b][m][n] = (f32x4){0.f, 0.f, 0.f, 0.f};
  bf16x8 At[4][2], B0[2][2], B1[2][2];
  const char* cA = (const char*)g.A + a_row0(g.rowmap, cur.pm) * lda * 2; const char* cB = (const char*)g.Bt + (size_t)cur.pn * 2 * hstepB;
  PG8_STAGE(PG8_SB(0, 0), cB, voffB); PG8_STAGE(PG8_SA(0, 0), cA, voffA); PG8_STAGE(PG8_SB(0, 1), cB + hstepB, voffB); PG8_STAGE(PG8_SA(0, 1), cA + hstepA, voffA);
  if (wr == 1) PG8_BAR;
  PG8_WAIT_V(4); PG8_BAR;
  PG8_STAGE(PG8_SB(1, 0), cB + kstep, voffB); PG8_STAGE(PG8_SA(1, 0), cA + kstep, voffA); PG8_STAGE(PG8_SB(1, 1), cB + hstepB + kstep, voffB);
  PG8_WAIT_V(6); PG8_BAR;
  for (;;) {
    const bool has_next = S.next(ui + 1, nxt);
    const char* nA = has_next ? (const char*)g.A + a_row0(g.rowmap, nxt.pm) * lda * 2 : cA; const char* nB = has_next ? (const char*)g.Bt + (size_t)nxt.pn * 2 * hstepB : cB;
    for (int t = 0; t < nt; t += 2) {
      const bool last = (t == nt - 2);
      const char* a1 = cA + (size_t)(t + 1) * kstep;
      const char* a2 = last ? nA : cA + (size_t)(t + 2) * kstep; const char* b2 = last ? nB : cB + (size_t)(t + 2) * kstep;
      const char* a3 = a2 + kstep; const char* b3 = b2 + kstep;
      PG8_LDB(B0, 0, 0); PG8_SCHED; PG8_LDA(At, 0, 0); PG8_STAGE(PG8_SA(1, 1), a1 + hstepA, voffA);
      PG8_WAIT_L(8); PG8_BAR; PG8_WAIT_L(0); PG8_MMA(0, 0, At, B0); PG8_BAR; PG8_SCHED;
      PG8_LDB(B1, 0, 1); PG8_STAGE(PG8_SB(0, 0), b2, voffB);
      PG8_BAR; PG8_WAIT_L(0); PG8_MMA(0, 1, At, B1); PG8_BAR;
      PG8_LDA(At, 0, 1); PG8_STAGE(PG8_SA(0, 0), a2, voffA);
      PG8_BAR; PG8_WAIT_L(0); PG8_MMA(1, 0, At, B0); PG8_BAR; PG8_SCHED;
      PG8_STAGE(PG8_SB(0, 1), b2 + hstepB, voffB);
      PG8_WAIT_V(6); PG8_BAR; PG8_MMA(1, 1, At, B1); PG8_BAR;
      PG8_LDB(B0, 1, 0); PG8_SCHED; PG8_LDA(At, 1, 0); PG8_STAGE(PG8_SA(0, 1), a2 + hstepA, voffA);
      PG8_WAIT_L(8); PG8_BAR; PG8_WAIT_L(0); PG8_MMA(0, 0, At, B0); PG8_BAR; PG8_SCHED;
      PG8_LDB(B1, 1, 1); PG8_STAGE(PG8_SB(1, 0), b3, voffB);
      PG8_BAR; PG8_WAIT_L(0); PG8_MMA(0, 1, At, B1); PG8_BAR;
      PG8_LDA(At, 1, 1); PG8_STAGE(PG8_SA(1, 0), a3, voffA);
      PG8_BAR; PG8_WAIT_L(0); PG8_MMA(1, 0, At, B0); PG8_BAR; PG8_SCHED;
      PG8_STAGE(PG8_SB(1, 1), b3 + hstepB, voffB);
      PG8_WAIT_V(6); PG8_BAR; PG8_MMA(1, 1, At, B1); PG8_BAR;
    }
    if constexpr (!Epi::AFTER_DRAIN) E(acc, cur, wr, wc, fr, fq);
    if (!has_next) break;
#pragma unroll
    for (int a = 0; a < 2; ++a)
#pragma unroll
      for (int b = 0; b < 2; ++b)
#pragma unroll
        for (int m = 0; m < 4; ++m)
#pragma unroll
          for (int n = 0; n < 2; ++n) acc[a][b][m][n] = (f32x4){0.f, 0.f, 0.f, 0.f};
    cur = nxt; cA = nA; cB = nB; ++ui;
  }
  PG8_WAIT_V(0);
  if (wr == 0) PG8_BAR;
  PG8_BAR;
  if constexpr (Epi::AFTER_DRAIN) E.fused(acc, cur, wr, wc, fr, fq, lds);
#undef PG8_SA
#undef PG8_SB
#undef PG8_STAGE
#undef PG8_LDA
#undef PG8_LDB
#undef PG8_MMA
#undef PG8_WAIT_V
#undef PG8_WAIT_L
#undef PG8_BAR
#undef PG8_SCHED
}

struct EpiBf16 {
  static constexpr bool PERM = true, AFTER_DRAIN = false;
  bf16_t* O; int ldc;
  __device__ __forceinline__ void operator()(const f32x4 (&acc)[2][2][4][2], const Unit& u, int wr, int wc, int fr, int fq) const {
    const int row0 = u.pm * BM + wr * 64 + fr, col0 = u.pn * BM + wc * 32 + 8 * fq;
#pragma unroll
    for (int ai = 0; ai < 2; ++ai)
#pragma unroll
      for (int m = 0; m < 4; ++m) { bf16_t* rowp = O + (size_t)(row0 + ai * HALF + m * 16) * ldc + col0;
#pragma unroll
        for (int bj = 0; bj < 2; ++bj) { const f32x4 v0 = acc[ai][bj][m][0], v1 = acc[ai][bj][m][1];
          u32x4 w; w.x = cvt_pk_bf16(v0[0], v0[1]); w.y = cvt_pk_bf16(v0[2], v0[3]); w.z = cvt_pk_bf16(v1[0], v1[1]); w.w = cvt_pk_bf16(v1[2], v1[3]);
          *(u32x4*)(rowp + bj * HALF) = w; } }
  }
};
struct EpiOutProj {
  static constexpr bool PERM = false, AFTER_DRAIN = false;
  float* C; const float* x;
  __device__ __forceinline__ void operator()(const f32x4 (&acc)[2][2][4][2], const Unit& u, int wr, int wc, int fr, int fq) const {
    const int l0 = wr * 64 + fr, col0 = u.pn * BM + wc * 32 + 4 * fq;
    const size_t brow = a_row0(1, u.pm);
#pragma unroll
    for (int ai = 0; ai < 2; ++ai)
#pragma unroll
      for (int m = 0; m < 4; ++m) { const int l = l0 + ai * HALF + m * 16;
        const float* src = x + ((size_t)u.pm * BM + l) * DM + col0;
        float* rowp = C + (brow + l) * DM + col0;
#pragma unroll
        for (int bj = 0; bj < 2; ++bj)
#pragma unroll
          for (int n = 0; n < 2; ++n) { const f32x4 h = *(const f32x4*)(src + bj * HALF + n * 16); *(f32x4*)(rowp + bj * HALF + n * 16) = acc[ai][bj][m][n] + h * ALPHA; } }
  }
};
struct EpiUpAct {
  static constexpr bool PERM = true, AFTER_DRAIN = false;
  bf16_t* O; const bf16_t* G; const float* cw; const float* cb;
  __device__ __forceinline__ void operator()(const f32x4 (&acc)[2][2][4][2], const Unit& u, int wr, int wc, int fr, int fq) const {
    const int row0 = u.pm * BM + wr * 64 + fr, col0 = u.pn * BM + wc * 32 + 8 * fq;
#pragma unroll
    for (int bj = 0; bj < 2; ++bj) { const int c = col0 + bj * HALF;
      float w0[8], w1[8], w2[8], bb[8];
#pragma unroll
      for (int j = 0; j < 8; ++j) { w0[j] = cw[c + j]; w1[j] = cw[DFF + c + j]; w2[j] = cw[2 * DFF + c + j]; bb[j] = cb[c + j]; }
#pragma unroll
      for (int ai = 0; ai < 2; ++ai)
#pragma unroll
        for (int m = 0; m < 4; ++m) { const int r = row0 + ai * HALF + m * 16; const int r1 = r > 0 ? r - 1 : 0, r2 = r > 1 ? r - 2 : 0;
          const u32x4 g0 = *(const u32x4*)(G + (size_t)r * DFF + c), g1 = *(const u32x4*)(G + (size_t)r1 * DFF + c), g2 = *(const u32x4*)(G + (size_t)r2 * DFF + c);
          const f32x4 v0 = acc[ai][bj][m][0], v1 = acc[ai][bj][m][1];
          float up[8] = {v0[0], v0[1], v0[2], v0[3], v1[0], v1[1], v1[2], v1[3]}, o[8];
#pragma unroll
          for (int j = 0; j < 8; ++j) { const unsigned a0 = g0[j >> 1], a1 = g1[j >> 1], a2 = g2[j >> 1];
            const float x0 = (j & 1) ? bfhi(a0) : bflo(a0), x1 = (j & 1) ? bfhi(a1) : bflo(a1), x2 = (j & 1) ? bfhi(a2) : bflo(a2);
            const float hh = w2[j] * x0 + w1[j] * x1 + w0[j] * x2 + bb[j]; o[j] = siluf(hh) * up[j]; }
          u32x4 w; w.x = cvt_pk_bf16(o[0], o[1]); w.y = cvt_pk_bf16(o[2], o[3]); w.z = cvt_pk_bf16(o[4], o[5]); w.w = cvt_pk_bf16(o[6], o[7]);
          *(u32x4*)(O + (size_t)r * DFF + c) = w; } }
  }
};
struct EpiDown {
  static constexpr bool PERM = false, AFTER_DRAIN = false;
  float* C;
  __device__ __forceinline__ void operator()(const f32x4 (&acc)[2][2][4][2], const Unit& u, int wr, int wc, int fr, int fq) const {
    const int row0 = u.pm * BM + wr * 64 + fr, col0 = u.pn * BM + wc * 32 + 4 * fq;
#pragma unroll
    for (int ai = 0; ai < 2; ++ai)
#pragma unroll
      for (int m = 0; m < 4; ++m) { float* rowp = C + (size_t)(row0 + ai * HALF + m * 16) * DM + col0;
#pragma unroll
        for (int bj = 0; bj < 2; ++bj)
#pragma unroll
          for (int n = 0; n < 2; ++n) { const f32x4 h = *(const f32x4*)(rowp + bj * HALF + n * 16); *(f32x4*)(rowp + bj * HALF + n * 16) = acc[ai][bj][m][n] + h * ALPHA; } }
  }
};

struct EpiDownLN {
  static constexpr bool PERM = false, AFTER_DRAIN = true;
  float* C; const float* gam; const float* bet; unsigned long long* slots; unsigned* cnt;
  __device__ __forceinline__ void fused(f32x4 (&acc)[2][2][4][2], const Unit& u, int wr, int wc, int fr, int fq, LAS unsigned char* lds) const {
    const int tid = threadIdx.x;
    const int row0 = u.pm * BM + wr * 64 + fr, col0 = u.pn * BM + wc * 32 + 4 * fq;
    LAS f32x2* part = (LAS f32x2*)lds;
    LAS f32x2* stat = (LAS f32x2*)(lds + 8192);
#pragma unroll
    for (int ai = 0; ai < 2; ++ai)
#pragma unroll
      for (int m = 0; m < 4; ++m) { const float* rowp = C + (size_t)(row0 + ai * HALF + m * 16) * DM + col0;
        float s1 = 0.f, s2 = 0.f;
#pragma unroll
        for (int bj = 0; bj < 2; ++bj)
#pragma unroll
          for (int n = 0; n < 2; ++n) { const f32x4 h = *(const f32x4*)(rowp + bj * HALF + n * 16); const f32x4 v = acc[ai][bj][m][n] + h * ALPHA; acc[ai][bj][m][n] = v;
            s1 += (v[0] + v[1]) + (v[2] + v[3]); s2 += (v[0] * v[0] + v[1] * v[1]) + (v[2] * v[2] + v[3] * v[3]); }
        s1 += __shfl_xor(s1, 16); s1 += __shfl_xor(s1, 32); s2 += __shfl_xor(s2, 16); s2 += __shfl_xor(s2, 32);
        if (fq == 0) part[(ai * HALF + wr * 64 + m * 16 + fr) * 4 + wc] = (f32x2){s1, s2};
      }
    __syncthreads();
    if (tid < 256) {
      const f32x2 p0 = part[tid * 4 + 0], p1 = part[tid * 4 + 1], p2 = part[tid * 4 + 2], p3 = part[tid * 4 + 3];
      const float t1 = (p0.x + p1.x) + (p2.x + p3.x), t2 = (p0.y + p1.y) + (p2.y + p3.y);
      __hip_atomic_store(slots + ((size_t)(u.pm * BM + tid) * 8 + u.pn), ((unsigned long long)__float_as_uint(t2) << 32) | __float_as_uint(t1), __ATOMIC_RELAXED, __HIP_MEMORY_SCOPE_AGENT);
    }
    asm volatile("s_waitcnt vmcnt(0)" ::: "memory");
    __syncthreads();
    if (tid == 0) {
      __hip_atomic_fetch_add(cnt + 64 * u.pm, 1u, __ATOMIC_RELAXED, __HIP_MEMORY_SCOPE_AGENT);
      unsigned sp = 0;
      while (__hip_atomic_load(cnt + 64 * u.pm, __ATOMIC_RELAXED, __HIP_MEMORY_SCOPE_AGENT) < 8u) { __builtin_amdgcn_s_sleep(1); if (++sp > (1u << 22)) break; }
      __builtin_amdgcn_fence(__ATOMIC_ACQUIRE, "agent");
      asm volatile("s_waitcnt vmcnt(0)" ::: "memory");
    }
    __syncthreads();
    if (tid < 256) {
      float t1 = 0.f, t2 = 0.f;
#pragma unroll
      for (int t = 0; t < 8; ++t) { const unsigned long long w = __hip_atomic_load(slots + ((size_t)(u.pm * BM + tid) * 8 + t), __ATOMIC_RELAXED, __HIP_MEMORY_SCOPE_AGENT);
        t1 += __uint_as_float((unsigned)w); t2 += __uint_as_float((unsigned)(w >> 32)); }
      const float mean = t1 * (1.f / DM);
      const float var = fmaxf(t2 * (1.f / DM) - mean * mean, 0.f);
      stat[tid] = (f32x2){mean, rsqrtf(var + 1e-5f)};
    }
    __syncthreads();
    f32x4 gv[2][2], bv[2][2];
#pragma unroll
    for (int bj = 0; bj < 2; ++bj)
#pragma unroll
      for (int n = 0; n < 2; ++n) { gv[bj][n] = *(const f32x4*)(gam + col0 + bj * HALF + n * 16); bv[bj][n] = *(const f32x4*)(bet + col0 + bj * HALF + n * 16); }
#pragma unroll
    for (int ai = 0; ai < 2; ++ai)
#pragma unroll
      for (int m = 0; m < 4; ++m) { const f32x2 st = stat[ai * HALF + wr * 64 + m * 16 + fr]; float* rowp = C + (size_t)(row0 + ai * HALF + m * 16) * DM + col0;
#pragma unroll
        for (int bj = 0; bj < 2; ++bj)
#pragma unroll
          for (int n = 0; n < 2; ++n) *(f32x4*)(rowp + bj * HALF + n * 16) = (acc[ai][bj][m][n] - st.x) * st.y * gv[bj][n] + bv[bj][n]; }
    __syncthreads();
  }
};
struct EpiOutProjLN {
  static constexpr bool PERM = false, AFTER_DRAIN = true;
  const float* x; float* hf; bf16_t* hb; const float* gam; const float* bet; unsigned long long* slots; unsigned* cnt; const XcdBarrier* xb;
  __device__ __forceinline__ void fused(f32x4 (&acc)[2][2][4][2], const Unit& u, int wr, int wc, int fr, int fq, LAS unsigned char* lds) const {
    const int tid = threadIdx.x;
    const int l0 = wr * 64 + fr, col0 = u.pn * BM + wc * 32 + 4 * fq;
    const size_t brow = a_row0(1, u.pm);
    LAS f32x2* part = (LAS f32x2*)lds;
    LAS f32x2* stat = (LAS f32x2*)(lds + 8192);
#pragma unroll
    for (int ai = 0; ai < 2; ++ai)
#pragma unroll
      for (int m = 0; m < 4; ++m) { const float* rowp = x + ((size_t)u.pm * BM + l0 + ai * HALF + m * 16) * DM + col0;
        float s1 = 0.f, s2 = 0.f;
#pragma unroll
        for (int bj = 0; bj < 2; ++bj)
#pragma unroll
          for (int n = 0; n < 2; ++n) { const f32x4 h = *(const f32x4*)(rowp + bj * HALF + n * 16); const f32x4 v = acc[ai][bj][m][n] + h * ALPHA; acc[ai][bj][m][n] = v;
            s1 += (v[0] + v[1]) + (v[2] + v[3]); s2 += (v[0] * v[0] + v[1] * v[1]) + (v[2] * v[2] + v[3] * v[3]); }
        s1 += __shfl_xor(s1, 16); s1 += __shfl_xor(s1, 32); s2 += __shfl_xor(s2, 16); s2 += __shfl_xor(s2, 32);
        if (fq == 0) part[(ai * HALF + l0 + m * 16) * 4 + wc] = (f32x2){s1, s2};
      }
    __syncthreads();
    if (tid < 256) {
      const f32x2 p0 = part[tid * 4 + 0], p1 = part[tid * 4 + 1], p2 = part[tid * 4 + 2], p3 = part[tid * 4 + 3];
      const float t1 = (p0.x + p1.x) + (p2.x + p3.x), t2 = (p0.y + p1.y) + (p2.y + p3.y);
      __hip_atomic_store(slots + ((size_t)(u.pm * BM + tid) * 8 + u.pn), ((unsigned long long)__float_as_uint(t2) << 32) | __float_as_uint(t1), __ATOMIC_RELAXED, __HIP_MEMORY_SCOPE_AGENT);
    }
    asm volatile("s_waitcnt vmcnt(0)" ::: "memory");
    __syncthreads();
    if (tid == 0) {
      __hip_atomic_fetch_add(cnt + 64 * u.pm, 1u, __ATOMIC_RELAXED, __HIP_MEMORY_SCOPE_AGENT);
      unsigned sp = 0;
      while (__hip_atomic_load(cnt + 64 * u.pm, __ATOMIC_RELAXED, __HIP_MEMORY_SCOPE_AGENT) < 8u) { __builtin_amdgcn_s_sleep(1); if (++sp > (1u << 22)) break; }
      __builtin_amdgcn_fence(__ATOMIC_ACQUIRE, "agent");
      asm volatile("s_waitcnt vmcnt(0)" ::: "memory");
    }
    __syncthreads();
    if (tid < 256) {
      float t1 = 0.f, t2 = 0.f;
#pragma unroll
      for (int t = 0; t < 8; ++t) { const unsigned long long w = __hip_atomic_load(slots + ((size_t)(u.pm * BM + tid) * 8 + t), __ATOMIC_RELAXED, __HIP_MEMORY_SCOPE_AGENT);
        t1 += __uint_as_float((unsigned)w); t2 += __uint_as_float((unsigned)(w >> 32)); }
      const float mean = t1 * (1.f / DM);
      const float var = fmaxf(t2 * (1.f / DM) - mean * mean, 0.f);
      stat[tid] = (f32x2){mean, rsqrtf(var + 1e-5f)};
    }
    __syncthreads();
    xcd_barrier(*xb);
    f32x4 gv[2][2], bv[2][2];
#pragma unroll
    for (int bj = 0; bj < 2; ++bj)
#pragma unroll
      for (int n = 0; n < 2; ++n) { gv[bj][n] = *(const f32x4*)(gam + col0 + bj * HALF + n * 16); bv[bj][n] = *(const f32x4*)(bet + col0 + bj * HALF + n * 16); }
#pragma unroll
    for (int ai = 0; ai < 2; ++ai)
#pragma unroll
      for (int m = 0; m < 4; ++m) { const int l = l0 + ai * HALF + m * 16; const f32x2 st = stat[l];
        float* fo = hf + ((size_t)u.pm * BM + l) * DM + col0; bf16_t* bo = hb + (brow + l) * DM + col0;
#pragma unroll
        for (int bj = 0; bj < 2; ++bj)
#pragma unroll
          for (int n = 0; n < 2; ++n) { const f32x4 y = (acc[ai][bj][m][n] - st.x) * st.y * gv[bj][n] + bv[bj][n];
            *(f32x4*)(fo + bj * HALF + n * 16) = y; *(u32x2*)(bo + bj * HALF + n * 16) = (u32x2){cvt_pk_bf16(y[0], y[1]), cvt_pk_bf16(y[2], y[3])}; } }
    __syncthreads();
  }
};
}

__device__ __forceinline__ void transpose_item(const float* W, int K, int ldw, int N, bf16_t* WT, LAS float* scr, int item, int lane) {
  const int nblk = N / 64, kb = item / nblk, nb = item % nblk, k0 = 64 * kb, n0 = 64 * nb;
  float tv[64];
#pragma unroll
  for (int i = 0; i < 64; ++i) tv[i] = __builtin_nontemporal_load(&W[(size_t)(k0 + i) * ldw + n0 + lane]);
#pragma unroll
  for (int i = 0; i < 64; ++i) scr[i * 65 + lane] = tv[i];
  LDS_WAIT();
  const int c = lane & 7;
#pragma unroll
  for (int j = 0; j < 8; ++j) { const int n = (lane >> 3) + 8 * j; const LAS float* s = scr + (8 * c) * 65 + n;
    u32x4 o; o.x = cvt_pk_bf16(s[0 * 65], s[1 * 65]); o.y = cvt_pk_bf16(s[2 * 65], s[3 * 65]); o.z = cvt_pk_bf16(s[4 * 65], s[5 * 65]); o.w = cvt_pk_bf16(s[6 * 65], s[7 * 65]);
    *(u32x4*)(WT + (size_t)(n0 + n) * K + k0 + 8 * c) = o; }
  LDS_WAIT();
}
__device__ __forceinline__ void transpose_all(const float* W, int K, int ldw, int N, bf16_t* WT, LAS unsigned char* lds, int gw, int ngw, int wave, int lane) {
  LAS float* scr = (LAS float*)(lds + wave * 16640);
  const int nitems = (K / 64) * (N / 64);
  for (int it = gw; it < nitems; it += ngw) transpose_item(W, K, ldw, N, WT, scr, it, lane);
}

__device__ __forceinline__ void transpose_dyn(unsigned* cnt, const float* W1, bf16_t* WT1, const float* W2, bf16_t* WT2, int K, int ldw, int N, LAS unsigned char* lds, int wave, int lane) {
  LAS float* scr = (LAS float*)(lds + wave * 16640);
  const int n1 = (K / 64) * (N / 64), total = W2 ? 2 * n1 : n1;
  for (;;) {
    int it0 = 0;
    if (lane == 0) it0 = (int)atomicAdd(cnt, 8u);
    it0 = __builtin_amdgcn_readfirstlane(it0);
    if (it0 >= total) break;
    for (int it = it0; it < it0 + 8 && it < total; ++it) {
      if (it < n1) transpose_item(W1, K, ldw, N, WT1, scr, it, lane); else transpose_item(W2, K, ldw, N, WT2, scr, it - n1, lane);
    }
  }
}

__device__ __forceinline__ void p0_rows(const KArgs& a, LAS unsigned char* lds, int gw, int ngw, int lane) {
  const float* x = a.in[0]; const float* meta = a.in[1]; const float* win = a.in[2];
  bf16_t* H0 = (bf16_t*)(a.ws + WS_H0); float* BA = (float*)(a.ws + WS_BA);
  LAS float* wT = (LAS float*)lds;
  for (int k = threadIdx.x; k < DM; k += NTHR) {
    const float* wr = win + (size_t)k * INCOLS + NPROJ;
#pragma unroll
    for (int q = 0; q < 4; ++q) { const f32x4 w = *(const f32x4*)(wr + 4 * q);
#pragma unroll
      for (int e = 0; e < 4; ++e) wT[(4 * q + e) * DM + k] = w[e]; }
  }
  __syncthreads();
  for (int r = gw; r < R; r += ngw) {
    const int b = r / LPAD, p = r - b * LPAD, t = p - FPAD;
    u32x2* orow = (u32x2*)(H0 + (size_t)r * DM);
    if (t < 0) {
#pragma unroll
      for (int i = 0; i < 8; ++i) orow[lane + 64 * i] = (u32x2){0u, 0u};
      if (lane < 16) BA[(size_t)r * 16 + lane] = 0.f;
      continue;
    }
    const float* src = t < NMETA ? meta + (size_t)t * DM : x + ((size_t)b * SEQ + (t - NMETA)) * DM;
    f32x4 accv[16];
#pragma unroll
    for (int j = 0; j < 16; ++j) accv[j] = (f32x4){0.f, 0.f, 0.f, 0.f};
    f32x4 v[8];
#pragma unroll
    for (int i = 0; i < 8; ++i) v[i] = *(const f32x4*)(src + 4 * lane + 256 * i);
#pragma unroll
    for (int i = 0; i < 8; ++i) {
      orow[lane + 64 * i] = (u32x2){cvt_pk_bf16(v[i][0], v[i][1]), cvt_pk_bf16(v[i][2], v[i][3])};
#pragma unroll
      for (int j = 0; j < 16; ++j) { const f32x4 w = *(const LAS f32x4*)(wT + j * DM + 4 * lane + 256 * i);
        accv[j] = accv[j] + v[i] * w; }
    }
    float acc[16];
#pragma unroll
    for (int j = 0; j < 16; ++j) acc[j] = (accv[j][0] + accv[j][1]) + (accv[j][2] + accv[j][3]);
#pragma unroll
    for (int j = 0; j < 16; ++j) acc[j] = wave_sum(acc[j]);
    float mine = 0.f;
#pragma unroll
    for (int j = 0; j < 16; ++j) mine = (lane == j) ? acc[j] : mine;
    if (lane < 16) BA[(size_t)r * 16 + lane] = mine;
  }
  __syncthreads();
}

__device__ const double ROPE_INVF[32] = {1.0, 0.7498942093324559, 0.5623413251903491, 0.4216965034285822, 0.31622776601683794, 0.23713737056616552, 0.1778279410038923, 0.1333521432163324, 0.1, 0.07498942093324558, 0.05623413251903491, 0.042169650342858224, 0.03162277660168379, 0.023713737056616554, 0.01778279410038923, 0.01333521432163324, 0.01, 0.007498942093324558, 0.005623413251903491, 0.004216965034285823, 0.0031622776601683794, 0.0023713737056616554, 0.0017782794100389228, 0.001333521432163324, 0.001, 0.0007498942093324559, 0.0005623413251903491, 0.00042169650342858224, 0.00031622776601683794, 0.00023713737056616554, 0.00017782794100389227, 0.0001333521432163324};
constexpr float QSCALE = 0.18033688011112042f;
__device__ __forceinline__ void sincos_red(double ang, float& s, float& c) {
  const double n = __builtin_rint(ang * 0.15915494309189535);
  const float r = (float)__builtin_fma(-n, 6.283185307179586, ang);
  s = __sinf(r); c = __cosf(r);
}
__device__ __forceinline__ void p2_rope(const KArgs& a, int gw, int ngw, int lane) {
  const bf16_t* P = (const bf16_t*)(a.ws + WS_P);
  bf16_t* QR = (bf16_t*)(a.ws + WS_QR); bf16_t* KR = (bf16_t*)(a.ws + WS_KR);
  const int ip = lane & 15;
  const double f0 = ROPE_INVF[2 * ip], f1 = ROPE_INVF[2 * ip + 1];
  for (int r = gw; r < R; r += ngw) {
    const int p = r % LPAD, t = p - FPAD;
    float s0, c0, s1, c1; sincos_red((double)t * f0, s0, c0); sincos_red((double)t * f1, s1, c1);
#pragma unroll
    for (int j = 0; j < 8; ++j) {
      const int grp = (lane >> 4) + 4 * j;
      const bf16_t* src = P + (size_t)r * NPROJ + grp * 64 + 2 * ip;
      const unsigned lo = *(const unsigned*)src, hi = *(const unsigned*)(src + 32);
      const float x1a = bflo(lo), x1b = bfhi(lo), x2a = bflo(hi), x2b = bfhi(hi);
      const float sc = grp < 16 ? QSCALE : 1.f;
      const float o1a = (x1a * c0 - x2a * s0) * sc, o1b = (x1b * c1 - x2b * s1) * sc, o2a = (x2a * c0 + x1a * s0) * sc, o2b = (x2b * c1 + x1b * s1) * sc;
      bf16_t* dst = (grp < 16 ? QR + (size_t)r * 1024 + grp * 64 : KR + (size_t)r * 1024 + (grp - 16) * 64) + 2 * ip;
      *(unsigned*)dst = cvt_pk_bf16(o1a, o1b); *(unsigned*)(dst + 32) = cvt_pk_bf16(o2a, o2b);
    }
  }
}

__device__ __forceinline__ int perm_k32(int k) { return 8 * ((k & 15) >> 2) + 4 * (k >> 4) + (k & 3); }
constexpr int PR_QN = 0, PR_KN = 17408, PR_RHS = 34816, PR_MT = 100352, PR_GC = 116736;
__device__ __forceinline__ void prep_stepA(const KArgs& a, LAS unsigned char* lds, int item, int slot, int lane) {
  const int bh = item / NCH, ch = item - bh * NCH, b = bh >> 3, h = bh & 7;
  const int r0 = b * LPAD + ch * 64;
  const float* BA = (const float*)(a.ws + WS_BA);
  LAS float* gcs = (LAS float*)(lds + PR_GC + slot * 512); LAS float* betas = gcs + 64;
  const int t = ch * 64 + lane - FPAD;
  float beta = 0.f, gg = 0.f;
  if (t >= 0) {
    const float br = BA[(size_t)(r0 + lane) * 16 + h], ar = BA[(size_t)(r0 + lane) * 16 + 8 + h];
    beta = 1.f / (1.f + expf(-br));
    const float z = ar + a.in[5][h];
    const float sp = z > 20.f ? z : log1pf(expf(z));
    gg = -expf(a.in[4][h]) * sp;
  }
  float v = gg;
#pragma unroll
  for (int o = 1; o < 64; o <<= 1) { const float u = __shfl_up(v, o); if (lane >= o) v += u; }
  gcs[lane] = v; betas[lane] = beta;
  if (lane == 63) ((float*)(a.ws + WS_GL))[item] = expf(v);
}
__device__ __forceinline__ void prep_item(const KArgs& a, LAS unsigned char* lds, int item, int slot, int next_item) {
  const int tid = threadIdx.x, lane = fresh_lane(), wave = __builtin_amdgcn_readfirstlane(tid >> 6);
  const int bh = item / NCH, ch = item - bh * NCH, b = bh >> 3, h = bh & 7;
  const int r0 = b * LPAD + ch * 64;
  const bf16_t* P = (const bf16_t*)(a.ws + WS_P);
  unsigned char* ib = a.ws + WS_PREP + (size_t)item * PREP_ITEM;
  bf16_t* gW = (bf16_t*)ib; bf16_t* gQD = (bf16_t*)(ib + 16384); bf16_t* gKDT = (bf16_t*)(ib + 32768); bf16_t* gUT = (bf16_t*)(ib + 49152); bf16_t* gQK = (bf16_t*)(ib + 65536);
  LAS float* gcs = (LAS float*)(lds + PR_GC + slot * 512); LAS float* betas = gcs + 64;
  LAS float* rhs = (LAS float*)(lds + PR_RHS); LAS float* MT = (LAS float*)(lds + PR_MT);
  float kdv[16];
  {
    const int i = tid >> 3, seg = tid & 7, d0 = seg * 16;
    const float gci = gcs[i], gcl = gcs[63], bi = betas[i];
    const float eg = expf(gci), egl = expf(gcl - gci);
    float val[3][16];
#pragma unroll
    for (int T = 0; T < 3; ++T) {
      const int ccol = T * 1024 + h * 128 + d0;
      float acc[16];
#pragma unroll
      for (int e = 0; e < 16; ++e) acc[e] = 0.f;
      u32x4 xq[4][2]; f32x4 cq[4][4];
#pragma unroll
      for (int j = 0; j < 4; ++j) {
        const int pr = ch * 64 + i - 3 + j;
        const bf16_t* src = P + (size_t)(pr >= 0 ? r0 + i - 3 + j : r0 + i) * NPROJ + 3072 + ccol;
        xq[j][0] = *(const u32x4*)src; xq[j][1] = *(const u32x4*)(src + 8);
        const float* cw = a.in[3] + (size_t)j * 3072 + ccol;
#pragma unroll
        for (int q = 0; q < 4; ++q) cq[j][q] = *(const f32x4*)(cw + 4 * q);
      }
      __builtin_amdgcn_sched_barrier(0);
#pragma unroll
      for (int j = 0; j < 4; ++j) {
        const float vj = (ch * 64 + i - 3 + j) >= 0 ? 1.f : 0.f;
#pragma unroll
        for (int e = 0; e < 4; ++e) {
          acc[2 * e] += bflo(xq[j][0][e]) * (cq[j][e >> 1][2 * (e & 1)] * vj); acc[2 * e + 1] += bfhi(xq[j][0][e]) * (cq[j][e >> 1][2 * (e & 1) + 1] * vj);
          acc[8 + 2 * e] += bflo(xq[j][1][e]) * (cq[j][2 + (e >> 1)][2 * (e & 1)] * vj); acc[8 + 2 * e + 1] += bfhi(xq[j][1][e]) * (cq[j][2 + (e >> 1)][2 * (e & 1) + 1] * vj);
        }
      }
      float ss = 0.f;
#pragma unroll
      for (int e = 0; e < 16; ++e) { acc[e] = siluf(acc[e]); ss += acc[e] * acc[e]; }
      if (T < 2) {
        ss += __shfl_xor(ss, 1); ss += __shfl_xor(ss, 2); ss += __shfl_xor(ss, 4);
        const float rn = rsqrtf(ss + 1e-6f) * (T == 0 ? 0.08838834764831845f : 1.f);
#pragma unroll
        for (int e = 0; e < 16; ++e) acc[e] *= rn;
      }
#pragma unroll
      for (int e = 0; e < 16; ++e) val[T][e] = acc[e];
    }
    {
      u32x4 w0, w1;
      w0.x = cvt_pk_bf16(val[0][0], val[0][1]); w0.y = cvt_pk_bf16(val[0][2], val[0][3]); w0.z = cvt_pk_bf16(val[0][4], val[0][5]); w0.w = cvt_pk_bf16(val[0][6], val[0][7]);
      w1.x = cvt_pk_bf16(val[0][8], val[0][9]); w1.y = cvt_pk_bf16(val[0][10], val[0][11]); w1.z = cvt_pk_bf16(val[0][12], val[0][13]); w1.w = cvt_pk_bf16(val[0][14], val[0][15]);
      *(LAS u32x4*)(lds + PR_QN + i * 272 + d0 * 2) = w0; *(LAS u32x4*)(lds + PR_QN + i * 272 + d0 * 2 + 16) = w1;
      w0.x = cvt_pk_bf16(val[1][0], val[1][1]); w0.y = cvt_pk_bf16(val[1][2], val[1][3]); w0.z = cvt_pk_bf16(val[1][4], val[1][5]); w0.w = cvt_pk_bf16(val[1][6], val[1][7]);
      w1.x = cvt_pk_bf16(val[1][8], val[1][9]); w1.y = cvt_pk_bf16(val[1][10], val[1][11]); w1.z = cvt_pk_bf16(val[1][12], val[1][13]); w1.w = cvt_pk_bf16(val[1][14], val[1][15]);
      *(LAS u32x4*)(lds + PR_KN + i * 272 + d0 * 2) = w0; *(LAS u32x4*)(lds + PR_KN + i * 272 + d0 * 2 + 16) = w1;
    }
    {
      const int blk = 32 * (seg >> 1), h1 = seg & 1;
#pragma unroll
      for (int g4 = 0; g4 < 4; ++g4) {
        u32x2 w; w.x = cvt_pk_bf16(val[0][4 * g4] * eg, val[0][4 * g4 + 1] * eg); w.y = cvt_pk_bf16(val[0][4 * g4 + 2] * eg, val[0][4 * g4 + 3] * eg);
        *(u32x2*)(gQD + (size_t)i * 128 + blk + 8 * g4 + 4 * h1) = w;
      }
    }
#pragma unroll
    for (int e = 0; e < 16; ++e) kdv[e] = val[1][e] * egl;
#pragma unroll
    for (int q4 = 0; q4 < 4; ++q4) {
      *(LAS f32x4*)(rhs + i * 256 + d0 + 4 * q4) = (f32x4){val[2][4 * q4] * bi, val[2][4 * q4 + 1] * bi, val[2][4 * q4 + 2] * bi, val[2][4 * q4 + 3] * bi};
      const float kb = bi * eg;
      *(LAS f32x4*)(rhs + i * 256 + 128 + d0 + 4 * q4) = (f32x4){val[1][4 * q4] * kb, val[1][4 * q4 + 1] * kb, val[1][4 * q4 + 2] * kb, val[1][4 * q4 + 3] * kb};
    }
  }
  LBAR();
  {
    const int it = wave >> 1, fr = lane & 15, g = lane >> 4;
#pragma unroll
    for (int s2 = 0; s2 < 2; ++s2) {
      const int st = 2 * (wave & 1) + s2;
      f32x4 am = {0.f, 0.f, 0.f, 0.f}, aq = {0.f, 0.f, 0.f, 0.f};
      if (st <= it) {
#pragma unroll
        for (int ks = 0; ks < 4; ++ks) {
          const bf16x8 ak = *(const LAS bf16x8*)(lds + PR_KN + (it * 16 + fr) * 272 + (32 * ks + 8 * g) * 2);
          const bf16x8 aqf = *(const LAS bf16x8*)(lds + PR_QN + (it * 16 + fr) * 272 + (32 * ks + 8 * g) * 2);
          const bf16x8 bk = *(const LAS bf16x8*)(lds + PR_KN + (st * 16 + fr) * 272 + (32 * ks + 8 * g) * 2);
          am = __builtin_amdgcn_mfma_f32_16x16x32_bf16(ak, bk, am, 0, 0, 0);
          aq = __builtin_amdgcn_mfma_f32_16x16x32_bf16(aqf, bk, aq, 0, 0, 0);
        }
      }
      const int s = st * 16 + fr; const float gs = gcs[s];
      f32x4 mo;
#pragma unroll
      for (int rg = 0; rg < 4; ++rg) {
        const int i = it * 16 + 4 * g + rg;
        const float dec = i >= s ? expf(gcs[i] - gs) : 0.f;
        mo[rg] = i > s ? betas[i] * am[rg] * dec : 0.f;
        gQK[(size_t)i * 64 + 32 * (s >> 5) + perm_k32(s & 31)] = f2bf(aq[rg] * dec);
      }
      *(LAS f32x4*)(MT + s * 64 + it * 16 + 4 * g) = mo;
    }
  }
  LBAR();
  {
    const int i = tid >> 3, d0 = (tid & 7) * 16, pi = 32 * (i >> 5) + perm_k32(i & 31);
#pragma unroll
    for (int e = 0; e < 16; ++e) *(LAS bf16_t*)(lds + PR_QN + ((d0 + e) * 64 + pi) * 2) = f2bf(kdv[e]);
  }
  LBAR();
  if (tid >= 256) {
#pragma unroll
    for (int q = 0; q < 4; ++q) { const int c = (tid - 256) + 256 * q; *(u32x4*)((unsigned char*)gKDT + (size_t)c * 16) = *(const LAS u32x4*)(lds + PR_QN + c * 16); }
  }
  if (wave == 4 && next_item >= 0) prep_stepA(a, lds, next_item, slot ^ 1, lane);
  if (tid < 256) {
    f32x4 Xv[16];
#define X(i) Xv[(i) >> 2][(i) & 3]
#pragma unroll
    for (int i = 0; i < 64; ++i) X(i) = rhs[i * 256 + tid];
    f32x4 cb0[8], cb1[8];
#define SOLVE_LOAD(buf, s, lo4) do { _Pragma("unroll") for (int q_ = 0; q_ < 8; ++q_) if ((lo4) + 4 * q_ + 3 > (s)) buf[q_] = *(const LAS f32x4*)(MT + (s) * 64 + (lo4) + 4 * q_); } while (0)
#define SOLVE_APPLY(buf, s, lo4) do { const float xs_ = X(s); const f32x4 xs4_ = {xs_, xs_, xs_, xs_}; _Pragma("unroll") for (int q_ = 0; q_ < 8; ++q_) if ((lo4) + 4 * q_ + 3 > (s)) Xv[((lo4) >> 2) + q_] = Xv[((lo4) >> 2) + q_] - buf[q_] * xs4_; } while (0)
    SOLVE_LOAD(cb0, 0, 0);
#pragma unroll
    for (int s = 0; s < 32; s += 2) {
      SOLVE_LOAD(cb1, s + 1, 0); __builtin_amdgcn_sched_barrier(0);
      SOLVE_APPLY(cb0, s, 0);
      if (s + 2 < 32) SOLVE_LOAD(cb0, s + 2, 0); __builtin_amdgcn_sched_barrier(0);
      SOLVE_APPLY(cb1, s + 1, 0);
    }
    SOLVE_LOAD(cb0, 0, 32);
#pragma unroll
    for (int s = 0; s < 32; s += 2) {
      SOLVE_LOAD(cb1, s + 1, 32); __builtin_amdgcn_sched_barrier(0);
      SOLVE_APPLY(cb0, s, 32);
      if (s + 2 < 32) SOLVE_LOAD(cb0, s + 2, 32); __builtin_amdgcn_sched_barrier(0);
      SOLVE_APPLY(cb1, s + 1, 32);
    }
    SOLVE_LOAD(cb0, 32, 32);
#pragma unroll
    for (int s = 32; s < 64; s += 2) {
      SOLVE_LOAD(cb1, s + 1 < 63 ? s + 1 : 62, 32); __builtin_amdgcn_sched_barrier(0);
      SOLVE_APPLY(cb0, s, 32);
      if (s + 2 < 64) SOLVE_LOAD(cb0, s + 2, 32); __builtin_amdgcn_sched_barrier(0);
      if (s + 1 < 63) SOLVE_APPLY(cb1, s + 1, 32);
    }
#undef SOLVE_LOAD
#undef SOLVE_APPLY
    if (tid < 128) {
      const int uw = tid >> 5, uvt = (tid >> 4) & 1, ufr = tid & 15;
#pragma unroll
      for (int ct = 0; ct < 4; ++ct)
#pragma unroll
        for (int g4 = 0; g4 < 4; ++g4) {
          u32x2 w; w.x = cvt_pk_bf16(X(16 * ct + 4 * g4), X(16 * ct + 4 * g4 + 1)); w.y = cvt_pk_bf16(X(16 * ct + 4 * g4 + 2), X(16 * ct + 4 * g4 + 3));
          *(u32x2*)((unsigned char*)gUT + (size_t)((((uw * 4 + ct) * 2 + uvt) * 64) + 16 * g4 + ufr) * 8) = w;
        }
    } else {
      const int k = tid - 128, pk = 32 * (k >> 5) + perm_k32(k & 31);
#pragma unroll
      for (int i = 0; i < 64; ++i) gW[(size_t)i * 128 + pk] = f2bf(-X(i));
    }
  }
#undef X
  LBAR();
}

constexpr int SC_W = 0, SC_QD = 17408, SC_KDT = 34816, SC_QK = 53248, SC_O = 62464, SC_OSZ = 33792, SC_GL = SC_O + 2 * SC_OSZ;
__device__ __forceinline__ bf16x8 pack8(const f32x4 a, const f32x4 b) {
  u32x4 w; w.x = cvt_pk_bf16(a[0], a[1]); w.y = cvt_pk_bf16(a[2], a[3]); w.z = cvt_pk_bf16(b[0], b[1]); w.w = cvt_pk_bf16(b[2], b[3]);
  return __builtin_bit_cast(bf16x8, w);
}
#define SC_BAR() do { asm volatile("s_waitcnt lgkmcnt(0)" ::: "memory"); __builtin_amdgcn_s_barrier(); asm volatile("" ::: "memory"); } while (0)
__device__ __forceinline__ void scan_bh(const KArgs& a, LAS unsigned char* lds, int bh) {
  const int tid = threadIdx.x, lane = fresh_lane(), wave = __builtin_amdgcn_readfirstlane(tid >> 6), fr = lane & 15, g = lane >> 4;
  const int b = bh >> 3, h = bh & 7;
  bf16_t* P = (bf16_t*)(a.ws + WS_P);
  const float* GL = (const float*)(a.ws + WS_GL);
  const float* dnw = a.in[11];
  LAS float* gls = (LAS float*)(lds + SC_GL);
  LAS float* dnl = (LAS float*)(lds + SC_GL + 256);
  const bool cmp = wave < 4;
  const int ctid = tid & 255;
  f32x4 accS[8][2];
#pragma unroll
  for (int kt = 0; kt < 8; ++kt) { accS[kt][0] = (f32x4){0.f, 0.f, 0.f, 0.f}; accS[kt][1] = (f32x4){0.f, 0.f, 0.f, 0.f}; }
  u32x2 ut[4][2];
  u32x4 stA[14], stB[14]; u32x4 dzr[4];
  const bf16_t* dzbase = P + ((size_t)b * LPAD + (ctid >> 2)) * NPROJ + 6144 + h * 128 + 32 * (ctid & 3);
#define SC_ITEM(n) (a.ws + WS_PREP + (size_t)(bh * NCH + (n)) * PREP_ITEM)
#define SC_LOADU(n) do { const unsigned char* ib_ = SC_ITEM(n); _Pragma("unroll") for (int ct_ = 0; ct_ < 4; ++ct_) _Pragma("unroll") for (int vt_ = 0; vt_ < 2; ++vt_) \
    ut[ct_][vt_] = *(const u32x2*)(ib_ + 49152 + (size_t)((((wave * 4 + ct_) * 2 + vt_) * 64) + lane) * 8); } while (0)
#define SC_LOADT(st, n) do { const unsigned char* ib_ = SC_ITEM(n); _Pragma("unroll") for (int i_ = 0; i_ < 4; ++i_) { \
    st[i_] = *(const u32x4*)(ib_ + (size_t)(ctid + 256 * i_) * 16); st[4 + i_] = *(const u32x4*)(ib_ + 16384 + (size_t)(ctid + 256 * i_) * 16); st[8 + i_] = *(const u32x4*)(ib_ + 32768 + (size_t)(ctid + 256 * i_) * 16); } \
    st[12] = *(const u32x4*)(ib_ + 65536 + (size_t)ctid * 16); st[13] = *(const u32x4*)(ib_ + 65536 + (size_t)(ctid + 256) * 16); } while (0)
#define SC_LOADDZ(n) do { _Pragma("unroll") for (int i_ = 0; i_ < 4; ++i_) dzr[i_] = *(const u32x4*)(dzbase + (size_t)(n) * 64 * NPROJ + 8 * i_); } while (0)
#define SC_STORET(st) do { _Pragma("unroll") for (int i_ = 0; i_ < 4; ++i_) { const int q_ = ctid + 256 * i_; \
    *(LAS u32x4*)(lds + SC_W + (q_ >> 4) * 272 + (q_ & 15) * 16) = st[i_]; *(LAS u32x4*)(lds + SC_QD + (q_ >> 4) * 272 + (q_ & 15) * 16) = st[4 + i_]; \
    *(LAS u32x4*)(lds + SC_KDT + (q_ >> 3) * 144 + (q_ & 7) * 16) = st[8 + i_]; } \
    *(LAS u32x4*)(lds + SC_QK + (ctid >> 3) * 144 + (ctid & 7) * 16) = st[12]; *(LAS u32x4*)(lds + SC_QK + ((ctid + 256) >> 3) * 144 + (ctid & 7) * 16) = st[13]; } while (0)
#define SC_NORM(n, ZQ) do { const int c_ = ctid >> 2, sg_ = ctid & 3; const LAS float* ob_ = (const LAS float*)(lds + SC_O + ((n) & 1) * SC_OSZ) + c_ * 132 + 32 * sg_; \
    float o_[32]; float ss_ = 0.f; \
    _Pragma("unroll") for (int q_ = 0; q_ < 8; ++q_) { const f32x4 v_ = *(const LAS f32x4*)(ob_ + 4 * q_); o_[4 * q_] = v_[0]; o_[4 * q_ + 1] = v_[1]; o_[4 * q_ + 2] = v_[2]; o_[4 * q_ + 3] = v_[3]; } \
    _Pragma("unroll") for (int e_ = 0; e_ < 32; ++e_) ss_ += o_[e_] * o_[e_]; \
    ss_ += __shfl_xor(ss_, 1); ss_ += __shfl_xor(ss_, 2); \
    const float rstd_ = rsqrtf(ss_ * (1.f / 128.f) + 1e-6f); \
    bf16_t* dst_ = P + ((size_t)b * LPAD + (size_t)(n) * 64 + c_) * NPROJ + 1024 + h * 128 + 32 * sg_; \
    _Pragma("unroll") for (int i_ = 0; i_ < 4; ++i_) { float r_[8]; \
      _Pragma("unroll") for (int e_ = 0; e_ < 4; ++e_) { const float z0_ = bflo(ZQ[i_][e_]), z1_ = bfhi(ZQ[i_][e_]); \
        r_[2 * e_] = o_[8 * i_ + 2 * e_] * rstd_ * dnl[32 * sg_ + 8 * i_ + 2 * e_] * siluf(z0_); r_[2 * e_ + 1] = o_[8 * i_ + 2 * e_ + 1] * rstd_ * dnl[32 * sg_ + 8 * i_ + 2 * e_ + 1] * siluf(z1_); } \
      u32x4 w_; w_.x = cvt_pk_bf16(r_[0], r_[1]); w_.y = cvt_pk_bf16(r_[2], r_[3]); w_.z = cvt_pk_bf16(r_[4], r_[5]); w_.w = cvt_pk_bf16(r_[6], r_[7]); \
      *(u32x4*)(dst_ + 8 * i_) = w_; } } while (0)
  if (cmp) {
    SC_LOADU(0);
    SC_BAR();
    if (tid < NCH) gls[tid] = GL[bh * NCH + tid];
    SC_BAR();
    for (int n = 0; n < NCH; ++n) {
      const float gl = gls[n];
      f32x4 accV[4][2];
#pragma unroll
      for (int ct = 0; ct < 4; ++ct)
#pragma unroll
        for (int vt = 0; vt < 2; ++vt) accV[ct][vt] = (f32x4){bflo(ut[ct][vt].x), bfhi(ut[ct][vt].x), bflo(ut[ct][vt].y), bfhi(ut[ct][vt].y)};
      if (n + 1 < NCH) SC_LOADU(n + 1);
      bf16x8 Sf[4][2];
#pragma unroll
      for (int ks = 0; ks < 4; ++ks) { Sf[ks][0] = pack8(accS[2 * ks][0], accS[2 * ks + 1][0]); Sf[ks][1] = pack8(accS[2 * ks][1], accS[2 * ks + 1][1]); }
#define SC_FW(ct, ks) (*(const LAS bf16x8*)(lds + SC_W + (16 * (ct) + fr) * 272 + (32 * (ks) + 8 * g) * 2))
#define SC_FQ(ct, ks) (*(const LAS bf16x8*)(lds + SC_QD + (16 * (ct) + fr) * 272 + (32 * (ks) + 8 * g) * 2))
#define SC_FK(ct, ks) (*(const LAS bf16x8*)(lds + SC_QK + (16 * (ct) + fr) * 144 + (32 * (ks) + 8 * g) * 2))
#define SC_FD(kt, ks) (*(const LAS bf16x8*)(lds + SC_KDT + (16 * (kt) + fr) * 144 + (32 * (ks) + 8 * g) * 2))
      bf16x8 fa[8], fb[8];
      LAS float* ob = (LAS float*)(lds + SC_O + (n & 1) * SC_OSZ);
#pragma unroll
      for (int ks = 0; ks < 4; ++ks) { fa[ks] = SC_FW(0, ks); fa[4 + ks] = SC_FW(1, ks); }
#pragma unroll
      for (int ks = 0; ks < 4; ++ks) { fb[ks] = SC_FW(2, ks); fb[4 + ks] = SC_FW(3, ks); }
      __builtin_amdgcn_sched_barrier(0);
#pragma unroll
      for (int ks = 0; ks < 4; ++ks)
#pragma unroll
        for (int vt = 0; vt < 2; ++vt) {
          accV[0][vt] = __builtin_amdgcn_mfma_f32_16x16x32_bf16(fa[ks], Sf[ks][vt], accV[0][vt], 0, 0, 0);
          accV[1][vt] = __builtin_amdgcn_mfma_f32_16x16x32_bf16(fa[4 + ks], Sf[ks][vt], accV[1][vt], 0, 0, 0);
        }
      __builtin_amdgcn_sched_barrier(0);
#pragma unroll
      for (int ks = 0; ks < 4; ++ks) { fa[ks] = SC_FQ(0, ks); fa[4 + ks] = SC_FQ(1, ks); }
      __builtin_amdgcn_sched_barrier(0);
#pragma unroll
      for (int ks = 0; ks < 4; ++ks)
#pragma unroll
        for (int vt = 0; vt < 2; ++vt) {
          accV[2][vt] = __builtin_amdgcn_mfma_f32_16x16x32_bf16(fb[ks], Sf[ks][vt], accV[2][vt], 0, 0, 0);
          accV[3][vt] = __builtin_amdgcn_mfma_f32_16x16x32_bf16(fb[4 + ks], Sf[ks][vt], accV[3][vt], 0, 0, 0);
        }
      __builtin_amdgcn_sched_barrier(0);
      f32x4 ao[2][2];
      bf16x8 Vf[2][2];
      fb[0] = SC_FK(0, 0); fb[1] = SC_FK(0, 1); fb[2] = SC_FK(1, 0); fb[3] = SC_FK(1, 1);
      __builtin_amdgcn_sched_barrier(0);
#pragma unroll
      for (int c1 = 0; c1 < 2; ++c1) { ao[c1][0] = (f32x4){0.f, 0.f, 0.f, 0.f}; ao[c1][1] = (f32x4){0.f, 0.f, 0.f, 0.f}; }
#pragma unroll
      for (int ks = 0; ks < 4; ++ks)
#pragma unroll
        for (int vt = 0; vt < 2; ++vt) {
          ao[0][vt] = __builtin_amdgcn_mfma_f32_16x16x32_bf16(fa[ks], Sf[ks][vt], ao[0][vt], 0, 0, 0);
          ao[1][vt] = __builtin_amdgcn_mfma_f32_16x16x32_bf16(fa[4 + ks], Sf[ks][vt], ao[1][vt], 0, 0, 0);
        }
#pragma unroll
      for (int vt = 0; vt < 2; ++vt) { Vf[0][vt] = pack8(accV[0][vt], accV[1][vt]); Vf[1][vt] = pack8(accV[2][vt], accV[3][vt]); }
      __builtin_amdgcn_sched_barrier(0);
#pragma unroll
      for (int ks = 0; ks < 4; ++ks) { fa[ks] = SC_FQ(2, ks); fa[4 + ks] = SC_FQ(3, ks); }
      __builtin_amdgcn_sched_barrier(0);
#pragma unroll
      for (int ks = 0; ks < 2; ++ks)
#pragma unroll
        for (int vt = 0; vt < 2; ++vt) {
          ao[0][vt] = __builtin_amdgcn_mfma_f32_16x16x32_bf16(fb[ks], Vf[ks][vt], ao[0][vt], 0, 0, 0);
          ao[1][vt] = __builtin_amdgcn_mfma_f32_16x16x32_bf16(fb[2 + ks], Vf[ks][vt], ao[1][vt], 0, 0, 0);
        }
      __builtin_amdgcn_sched_barrier(0);
      fb[4] = SC_FK(2, 0); fb[5] = SC_FK(2, 1); fb[6] = SC_FK(3, 0); fb[7] = SC_FK(3, 1);
#pragma unroll
      for (int c1 = 0; c1 < 2; ++c1)
#pragma unroll
        for (int vt = 0; vt < 2; ++vt)
#pragma unroll
          for (int rg = 0; rg < 4; ++rg) ob[(16 * c1 + 4 * g + rg) * 132 + 32 * wave + 16 * vt + fr] = ao[c1][vt][rg];
      __builtin_amdgcn_sched_barrier(0);
#pragma unroll
      for (int c1 = 0; c1 < 2; ++c1) { ao[c1][0] = (f32x4){0.f, 0.f, 0.f, 0.f}; ao[c1][1] = (f32x4){0.f, 0.f, 0.f, 0.f}; }
#pragma unroll
      for (int ks = 0; ks < 4; ++ks)
#pragma unroll
        for (int vt = 0; vt < 2; ++vt) {
          ao[0][vt] = __builtin_amdgcn_mfma_f32_16x16x32_bf16(fa[ks], Sf[ks][vt], ao[0][vt], 0, 0, 0);
          ao[1][vt] = __builtin_amdgcn_mfma_f32_16x16x32_bf16(fa[4 + ks], Sf[ks][vt], ao[1][vt], 0, 0, 0);
        }
      __builtin_amdgcn_sched_barrier(0);
#pragma unroll
      for (int k4 = 0; k4 < 4; ++k4) { fa[2 * k4] = SC_FD(k4, 0); fa[2 * k4 + 1] = SC_FD(k4, 1); }
      __builtin_amdgcn_sched_barrier(0);
#pragma unroll
      for (int ks = 0; ks < 2; ++ks)
#pragma unroll
        for (int vt = 0; vt < 2; ++vt) {
          ao[0][vt] = __builtin_amdgcn_mfma_f32_16x16x32_bf16(fb[4 + ks], Vf[ks][vt], ao[0][vt], 0, 0, 0);
          ao[1][vt] = __builtin_amdgcn_mfma_f32_16x16x32_bf16(fb[6 + ks], Vf[ks][vt], ao[1][vt], 0, 0, 0);
        }
      __builtin_amdgcn_sched_barrier(0);
#pragma unroll
      for (int k4 = 0; k4 < 4; ++k4) { fb[2 * k4] = SC_FD(4 + k4, 0); fb[2 * k4 + 1] = SC_FD(4 + k4, 1); }
#pragma unroll
      for (int c1 = 0; c1 < 2; ++c1)
#pragma unroll
        for (int vt = 0; vt < 2; ++vt)
#pragma unroll
          for (int rg = 0; rg < 4; ++rg) ob[(32 + 16 * c1 + 4 * g + rg) * 132 + 32 * wave + 16 * vt + fr] = ao[c1][vt][rg];
#pragma unroll
      for (int kt = 0; kt < 8; ++kt) { accS[kt][0] = accS[kt][0] * gl; accS[kt][1] = accS[kt][1] * gl; }
      __builtin_amdgcn_sched_barrier(0);
#pragma unroll
      for (int ks = 0; ks < 2; ++ks)
#pragma unroll
        for (int k4 = 0; k4 < 4; ++k4)
#pragma unroll
          for (int vt = 0; vt < 2; ++vt) accS[k4][vt] = __builtin_amdgcn_mfma_f32_16x16x32_bf16(fa[2 * k4 + ks], Vf[ks][vt], accS[k4][vt], 0, 0, 0);
      __builtin_amdgcn_sched_barrier(0);
#pragma unroll
      for (int ks = 0; ks < 2; ++ks)
#pragma unroll
        for (int k4 = 0; k4 < 4; ++k4)
#pragma unroll
          for (int vt = 0; vt < 2; ++vt) accS[4 + k4][vt] = __builtin_amdgcn_mfma_f32_16x16x32_bf16(fb[2 * k4 + ks], Vf[ks][vt], accS[4 + k4][vt], 0, 0, 0);
#undef SC_FW
#undef SC_FQ
#undef SC_FK
#undef SC_FD
      SC_BAR();
      SC_BAR();
    }
    SC_BAR();
  } else {
    SC_LOADT(stA, 0);
    SC_BAR();
    if (ctid < 128) dnl[ctid] = dnw[ctid];
    SC_STORET(stA);
    SC_LOADT(stB, 1);
    SC_BAR();
    for (int n = 0; n < NCH; n += 2) {
      {
        u32x4 zc[4];
#pragma unroll
        for (int i = 0; i < 4; ++i) zc[i] = dzr[i];
        SC_LOADDZ(n);
        if (n + 2 == NCH - 1) {
          unsigned* fl = (unsigned*)(a.ws + WS_CNT + 2048) + 16 * bh; unsigned sp = 0;
          while (__hip_atomic_load(fl, __ATOMIC_RELAXED, __HIP_MEMORY_SCOPE_AGENT) == 0u) { __builtin_amdgcn_s_sleep(2); if (++sp > (1u << 22)) break; }
          __builtin_amdgcn_fence(__ATOMIC_ACQUIRE, "agent");
          asm volatile("s_waitcnt vmcnt(0)" ::: "memory");
          if (ctid == 0) gls[NCH - 1] = __hip_atomic_load((const float*)(a.ws + WS_GL + 65536) + 32 * bh, __ATOMIC_RELAXED, __HIP_MEMORY_SCOPE_AGENT);
        }
        if (n + 2 < NCH) SC_LOADT(stA, n + 2);
        if (n >= 1) SC_NORM(n - 1, zc);
        SC_BAR();
        if (n + 1 < NCH) SC_STORET(stB);
        SC_BAR();
      }
      if (n + 1 < NCH) {
        u32x4 zc[4];
#pragma unroll
        for (int i = 0; i < 4; ++i) zc[i] = dzr[i];
        SC_LOADDZ(n + 1);
        if (n + 3 < NCH) SC_LOADT(stB, n + 3);
        SC_NORM(n, zc);
        SC_BAR();
        if (n + 2 < NCH) SC_STORET(stA);
        SC_BAR();
      }
    }
    SC_NORM(NCH - 1, dzr);
    SC_BAR();
  }
#undef SC_ITEM
#undef SC_LOADU
#undef SC_LOADT
#undef SC_LOADDZ
#undef SC_STORET
#undef SC_NORM
#undef SC_BAR
  __syncthreads();
}

constexpr int AT_K1 = 0, AT_K2 = 9216, AT_V = 18432, AT_BUF = 34816, AT_O = 2 * AT_BUF;
__device__ __forceinline__ unsigned voff_b(unsigned row, unsigned ch) { return 256u * row + 16u * (ch ^ (((row & 3) << 2) | ((row >> 2) & 3))); }
__device__ __forceinline__ s16x4 tr_read(LAS unsigned char* p) { return __builtin_amdgcn_ds_read_tr16_b64_v4i16((LAS s16x4*)p); }
__device__ __forceinline__ float xsw16_max(float x) { auto r = __builtin_amdgcn_permlane16_swap(__float_as_uint(x), __float_as_uint(x), false, false); return fmaxf(__uint_as_float(r[0]), __uint_as_float(r[1])); }
__device__ __forceinline__ float xsw32_max(float x) { auto r = __builtin_amdgcn_permlane32_swap(__float_as_uint(x), __float_as_uint(x), false, false); return fmaxf(__uint_as_float(r[0]), __uint_as_float(r[1])); }
__device__ __forceinline__ float xsw16_sum(float x) { auto r = __builtin_amdgcn_permlane16_swap(__float_as_uint(x), __float_as_uint(x), false, false); return __uint_as_float(r[0]) + __uint_as_float(r[1]); }
__device__ __forceinline__ float xsw32_sum(float x) { auto r = __builtin_amdgcn_permlane32_swap(__float_as_uint(x), __float_as_uint(x), false, false); return __uint_as_float(r[0]) + __uint_as_float(r[1]); }
__device__ __forceinline__ void attn_item(const KArgs& a, LAS unsigned char* lds, int bh, int p, float lam) {
  const int tid = threadIdx.x, lane = fresh_lane(), wave = __builtin_amdgcn_readfirstlane(tid >> 6), fr = lane & 15, g = lane >> 4;
  const int b = bh >> 3, h = bh & 7, comp = wave >> 2, wq = wave & 3;
  const int cmine = 2 * p + (wq >> 1);
  const bool act = cmine < NCH;
  const int clast = (2 * p + 1 < NCH) ? 2 * p + 1 : NCH - 1;
  const bf16_t* QR = (const bf16_t*)(a.ws + WS_QR); const bf16_t* KR = (const bf16_t*)(a.ws + WS_KR);
  bf16_t* P = (bf16_t*)(a.ws + WS_P);
  const size_t rb = (size_t)b * LPAD;
  const size_t qrow0 = rb + (size_t)128 * p + 32 * wq + fr;
  bf16x8 Qf[2][2];
#pragma unroll
  for (int qt = 0; qt < 2; ++qt)
#pragma unroll
    for (int ks = 0; ks < 2; ++ks) Qf[qt][ks] = act ? *(const bf16x8*)(QR + (qrow0 + 16 * qt) * 1024 + h * 128 + comp * 64 + 32 * ks + 8 * g) : (bf16x8){0, 0, 0, 0, 0, 0, 0, 0};
  f32x4 accO[2][8];
#pragma unroll
  for (int qt = 0; qt < 2; ++qt)
#pragma unroll
    for (int et = 0; et < 8; ++et) accO[qt][et] = (f32x4){0.f, 0.f, 0.f, 0.f};
  float m[2] = {-INFINITY, -INFINITY}, lsum[2] = {0.f, 0.f};
  unsigned vaddr[8];
  { const unsigned q4 = (unsigned)fr >> 2, p4 = (unsigned)fr & 3, row0 = 4u * g + q4;
#pragma unroll
    for (int et = 0; et < 8; ++et) vaddr[et] = AT_V + voff_b(row0, 2u * et + (p4 >> 1)) + 8u * (p4 & 1); }
  u32x4 sk1, sk2, sv0, sv1;
  const int krow = tid >> 3, kch = tid & 7;
  const int vrow0 = tid >> 4, vch = tid & 15;
  const bf16_t* kp = KR + (rb + krow) * 1024 + h * 128 + kch * 8;
  const bf16_t* vp = P + (rb + vrow0) * NPROJ + 2048 + h * 128 + vch * 8;
#define AT_LOAD(kt) do { sk1 = *(const u32x4*)kp; sk2 = *(const u32x4*)(kp + 64); sv0 = *(const u32x4*)vp; sv1 = *(const u32x4*)(vp + (size_t)32 * NPROJ); \
    kp += 64 * 1024; vp += (size_t)64 * NPROJ; } while (0)
#define AT_STORE(bf) do { LAS unsigned char* l_ = lds + (bf) * AT_BUF; *(LAS u32x4*)(l_ + AT_K1 + krow * 144 + kch * 16) = sk1; *(LAS u32x4*)(l_ + AT_K2 + krow * 144 + kch * 16) = sk2; \
    *(LAS u32x4*)(l_ + AT_V + voff_b(vrow0, vch)) = sv0; *(LAS u32x4*)(l_ + AT_V + voff_b(vrow0 + 32, vch)) = sv1; } while (0)
  AT_LOAD(0);
  __syncthreads();
  AT_STORE(0);
  __syncthreads();
  for (int kt = 0; kt <= clast; ++kt) {
    LAS unsigned char* lb = lds + (kt & 1) * AT_BUF;
    LAS unsigned char* kbase = lb + (comp ? AT_K2 : AT_K1);
    if (kt < clast) AT_LOAD(kt + 1);
    if (act && kt <= cmine) {
      bf16x8 Pf[2][2];
      {
        f32x4 s[2][4];
        bf16x8 kf[4][2];
#pragma unroll
        for (int nt = 0; nt < 4; ++nt)
#pragma unroll
          for (int ks = 0; ks < 2; ++ks) kf[nt][ks] = *(const LAS bf16x8*)(kbase + (16 * nt + fr) * 144 + (32 * ks + 8 * g) * 2);
        __builtin_amdgcn_sched_barrier(0);
#pragma unroll
        for (int nt = 0; nt < 4; ++nt)
#pragma unroll
          for (int qt = 0; qt < 2; ++qt) s[qt][nt] = (f32x4){0.f, 0.f, 0.f, 0.f};
        __builtin_amdgcn_s_setprio(1);
#pragma unroll
        for (int ks = 0; ks < 2; ++ks)
#pragma unroll
          for (int nt = 0; nt < 4; ++nt)
#pragma unroll
            for (int qt = 0; qt < 2; ++qt) s[qt][nt] = __builtin_amdgcn_mfma_f32_16x16x32_bf16(kf[nt][ks], Qf[qt][ks], s[qt][nt], 0, 0, 0);
        __builtin_amdgcn_s_setprio(0);
        if (kt == 0) {
#pragma unroll
          for (int qt = 0; qt < 2; ++qt)
#pragma unroll
            for (int nt = 0; nt < 3; ++nt) s[qt][nt] = (f32x4){-INFINITY, -INFINITY, -INFINITY, -INFINITY};
        }
#pragma unroll
        for (int qt = 0; qt < 2; ++qt) {
          float mx = -INFINITY;
#pragma unroll
          for (int nt = 0; nt < 4; ++nt)
#pragma unroll
            for (int rg = 0; rg < 4; ++rg) mx = fmaxf(mx, s[qt][nt][rg]);
          mx = xsw16_max(mx); mx = xsw32_max(mx);
          const float mn = fmaxf(m[qt], mx);
          const float al = __builtin_amdgcn_exp2f(m[qt] - mn);
          const f32x4 mn4 = {mn, mn, mn, mn};
          f32x4 rs4 = {0.f, 0.f, 0.f, 0.f};
#pragma unroll
          for (int nt = 0; nt < 4; ++nt) { const f32x4 d = s[qt][nt] - mn4; f32x4 pv;
            pv[0] = __builtin_amdgcn_exp2f(d[0]); pv[1] = __builtin_amdgcn_exp2f(d[1]); pv[2] = __builtin_amdgcn_exp2f(d[2]); pv[3] = __builtin_amdgcn_exp2f(d[3]);
            s[qt][nt] = pv; rs4 = rs4 + pv; }
          float rs = (rs4[0] + rs4[1]) + (rs4[2] + rs4[3]);
          rs = xsw16_sum(rs); rs = xsw32_sum(rs);
          lsum[qt] = lsum[qt] * al + rs; m[qt] = mn;
#pragma unroll
          for (int et = 0; et < 8; ++et) accO[qt][et] = accO[qt][et] * al;
          Pf[qt][0] = pack8(s[qt][0], s[qt][1]); Pf[qt][1] = pack8(s[qt][2], s[qt][3]);
        }
      }
      {
        s16x4 va[2][8], vb[2][8];
#define AT_VLOAD(ks) do { _Pragma("unroll") for (int et_ = 0; et_ < 8; ++et_) { \
          va[ks][et_] = tr_read(lb + vaddr[et_] + (ks) * 8192); vb[ks][et_] = tr_read(lb + vaddr[et_] + (ks) * 8192 + 4096); } } while (0)
        AT_VLOAD(0);
        AT_VLOAD(1);
        __builtin_amdgcn_sched_barrier(0);
        __builtin_amdgcn_s_setprio(1);
#pragma unroll
        for (int ks = 0; ks < 2; ++ks)
#pragma unroll
          for (int et = 0; et < 8; ++et) {
            bf16x8 vf; vf[0] = va[ks][et][0]; vf[1] = va[ks][et][1]; vf[2] = va[ks][et][2]; vf[3] = va[ks][et][3]; vf[4] = vb[ks][et][0]; vf[5] = vb[ks][et][1]; vf[6] = vb[ks][et][2]; vf[7] = vb[ks][et][3];
            accO[0][et] = __builtin_amdgcn_mfma_f32_16x16x32_bf16(vf, Pf[0][ks], accO[0][et], 0, 0, 0);
            accO[1][et] = __builtin_amdgcn_mfma_f32_16x16x32_bf16(vf, Pf[1][ks], accO[1][et], 0, 0, 0);
          }
        __builtin_amdgcn_s_setprio(0);
#undef AT_VLOAD
      }
    }
    if (kt < clast) AT_STORE((kt + 1) & 1);
    __syncthreads();
  }
#pragma unroll
  for (int qt = 0; qt < 2; ++qt) {
    const float inv = act ? 1.f / lsum[qt] : 0.f;
#pragma unroll
    for (int et = 0; et < 8; ++et) accO[qt][et] = accO[qt][et] * inv;
  }
  if (comp == 1) {
#pragma unroll
    for (int qt = 0; qt < 2; ++qt) { LAS float* ob = (LAS float*)(lds + AT_O) + (wq * 32 + 16 * qt + fr) * 132;
#pragma unroll
      for (int et = 0; et < 8; ++et) *(LAS f32x4*)(ob + 16 * et + 4 * g) = accO[qt][et]; }
  }
  __syncthreads();
  if (comp == 0 && act) {
    const float* nw = a.in[10];
#pragma unroll
    for (int qt = 0; qt < 2; ++qt) {
      const LAS float* ob = (const LAS float*)(lds + AT_O) + (wq * 32 + 16 * qt + fr) * 132;
      float ss = 0.f;
#pragma unroll
      for (int et = 0; et < 8; ++et) { const f32x4 o2 = *(const LAS f32x4*)(ob + 16 * et + 4 * g); accO[qt][et] = accO[qt][et] - o2 * lam;
        ss += accO[qt][et][0] * accO[qt][et][0] + accO[qt][et][1] * accO[qt][et][1] + accO[qt][et][2] * accO[qt][et][2] + accO[qt][et][3] * accO[qt][et][3]; }
      ss = xsw16_sum(ss); ss = xsw32_sum(ss);
      const float rstd = rsqrtf(ss * (1.f / 128.f) + 1e-6f) * (1.f - LAM_INIT);
#pragma unroll
      for (int et = 0; et < 8; ++et) { const f32x4 w4 = *(const f32x4*)(nw + 16 * et + 4 * g);
        u32x2 w; w.x = cvt_pk_bf16(accO[qt][et][0] * rstd * w4[0], accO[qt][et][1] * rstd * w4[1]); w.y = cvt_pk_bf16(accO[qt][et][2] * rstd * w4[2], accO[qt][et][3] * rstd * w4[3]);
        *(u32x2*)(P + (qrow0 + 16 * qt) * NPROJ + h * 128 + 16 * et + 4 * g) = w; }
    }
  }
  __syncthreads();
#undef AT_LOAD
#undef AT_STORE
}

__device__ __forceinline__ void outproj_mini(const KArgs& a, int mu) {
  const int tid = threadIdx.x, ks = tid & 7, c8 = (tid >> 3) & 7, r8 = tid >> 6, c = 8 * mu + c8;
  const int b = r8 >> 1, t = 14 + (r8 & 1);
  const size_t row = (size_t)b * LPAD + FPAD + t;
  const bf16_t* arow = (const bf16_t*)(a.ws + WS_P) + row * NPROJ + 8 * ks;
  const bf16_t* wrow = (const bf16_t*)a.out + (size_t)c * DM + 8 * ks;
  float acc = 0.f;
#pragma unroll 8
  for (int k = 0; k < DM; k += 64) {
    const u32x4 av = *(const u32x4*)(arow + k), wv = *(const u32x4*)(wrow + k);
#pragma unroll
    for (int e = 0; e < 4; ++e) acc += bflo(av[e]) * bflo(wv[e]) + bfhi(av[e]) * bfhi(wv[e]);
  }
  acc += __shfl_xor(acc, 1); acc += __shfl_xor(acc, 2); acc += __shfl_xor(acc, 4);
  if (ks == 0) ((float*)(a.ws + WS_PRE1))[row * DM + c] = acc + ALPHA * a.in[1][(size_t)t * DM + c];
}

__device__ __forceinline__ void ln1_rows(const KArgs& a, int gw, int ngw, int lane) {
  const float* PRE = (const float*)(a.ws + WS_PRE1); bf16_t* H1B = (bf16_t*)(a.ws + WS_H1B);
  const float* gam = a.in[13]; const float* bet = a.in[14];
  f32x4 v[8];
  int r = gw;
#define LN1_T(rr) (((rr) % LPAD) - FPAD)
#define LN1_LOAD(dst, rr) do { const f32x4* xr_ = (const f32x4*)(PRE + (size_t)(rr) * DM) + lane; _Pragma("unroll") for (int i_ = 0; i_ < 8; ++i_) dst[i_] = xr_[64 * i_]; } while (0)
  if (r < R && LN1_T(r) >= 14) LN1_LOAD(v, r);
  while (r < R) {
    const int rn = r + ngw;
    const int b = r / LPAD, t = r - b * LPAD - FPAD;
    f32x4 w[8];
    if (rn < R && LN1_T(rn) >= 14) LN1_LOAD(w, rn);
    u32x2* orow = (u32x2*)(H1B + (size_t)r * DM);
    if (t < 14) {
#pragma unroll
      for (int i = 0; i < 8; ++i) orow[lane + 64 * i] = (u32x2){0u, 0u};
    } else {
      float s = 0.f;
#pragma unroll
      for (int i = 0; i < 8; ++i) s += (v[i][0] + v[i][1]) + (v[i][2] + v[i][3]);
      const float mean = wave_sum(s) * (1.f / DM); float s2 = 0.f;
#pragma unroll
      for (int i = 0; i < 8; ++i) { v[i] = v[i] - mean; s2 += (v[i][0] * v[i][0] + v[i][1] * v[i][1]) + (v[i][2] * v[i][2] + v[i][3] * v[i][3]); }
      const float rstd = rsqrtf(wave_sum(s2) * (1.f / DM) + 1e-5f);
      float* of = t >= NMETA ? a.out + ((size_t)b * SEQ + (t - NMETA)) * DM : nullptr;
#pragma unroll
      for (int i = 0; i < 8; ++i) {
        const f32x4 gg = *((const f32x4*)gam + lane + 64 * i), bb = *((const f32x4*)bet + lane + 64 * i);
        const f32x4 y = v[i] * rstd * gg + bb;
        orow[lane + 64 * i] = (u32x2){cvt_pk_bf16(y[0], y[1]), cvt_pk_bf16(y[2], y[3])};
        if (of) *((f32x4*)of + lane + 64 * i) = y;
      }
    }
#pragma unroll
    for (int i = 0; i < 8; ++i) v[i] = w[i];
    r = rn;
  }
#undef LN1_T
#undef LN1_LOAD
}
__device__ __forceinline__ void ln1_side_rows(const KArgs& a, int gw, int lane) {
  if (gw >= 8) return;
  const float* PRE = (const float*)(a.ws + WS_PRE1); bf16_t* H1B = (bf16_t*)(a.ws + WS_H1B);
  const float* gam = a.in[13]; const float* bet = a.in[14];
  const int r = (gw >> 1) * LPAD + FPAD + 14 + (gw & 1);
  const f32x4* xr = (const f32x4*)(PRE + (size_t)r * DM) + lane;
  u32x2* orow = (u32x2*)(H1B + (size_t)r * DM);
  f32x4 v[8]; float s = 0.f;
#pragma unroll
  for (int i = 0; i < 8; ++i) { v[i] = xr[64 * i]; s += (v[i][0] + v[i][1]) + (v[i][2] + v[i][3]); }
  const float mean = wave_sum(s) * (1.f / DM); float s2 = 0.f;
#pragma unroll
  for (int i = 0; i < 8; ++i) { v[i] = v[i] - mean; s2 += (v[i][0] * v[i][0] + v[i][1] * v[i][1]) + (v[i][2] * v[i][2] + v[i][3] * v[i][3]); }
  const float rstd = rsqrtf(wave_sum(s2) * (1.f / DM) + 1e-5f);
#pragma unroll
  for (int i = 0; i < 8; ++i) {
    const f32x4 gg = *((const f32x4*)gam + lane + 64 * i), bb = *((const f32x4*)bet + lane + 64 * i);
    const f32x4 y = v[i] * rstd * gg + bb;
    orow[lane + 64 * i] = (u32x2){cvt_pk_bf16(y[0], y[1]), cvt_pk_bf16(y[2], y[3])};
  }
}
__device__ __forceinline__ void ln2_rows(const KArgs& a, int gw, int ngw, int lane) {
  const float* gam = a.in[20]; const float* bet = a.in[21];
  f32x4 v[8];
  int r = gw;
  if (r < NB * SEQ) { const f32x4* xr = (const f32x4*)(a.out + (size_t)r * DM) + lane;
#pragma unroll
    for (int i = 0; i < 8; ++i) v[i] = xr[64 * i]; }
  while (r < NB * SEQ) {
    const int rn = r + ngw;
    f32x4 w[8];
    if (rn < NB * SEQ) { const f32x4* xn = (const f32x4*)(a.out + (size_t)rn * DM) + lane;
#pragma unroll
      for (int i = 0; i < 8; ++i) w[i] = xn[64 * i]; }
    f32x4* xr = (f32x4*)(a.out + (size_t)r * DM) + lane;
    float s = 0.f;
#pragma unroll
    for (int i = 0; i < 8; ++i) s += (v[i][0] + v[i][1]) + (v[i][2] + v[i][3]);
    const float mean = wave_sum(s) * (1.f / DM); float s2 = 0.f;
#pragma unroll
    for (int i = 0; i < 8; ++i) { v[i] = v[i] - mean; s2 += (v[i][0] * v[i][0] + v[i][1] * v[i][1]) + (v[i][2] * v[i][2] + v[i][3] * v[i][3]); }
    const float rstd = rsqrtf(wave_sum(s2) * (1.f / DM) + 1e-5f);
#pragma unroll
    for (int i = 0; i < 8; ++i) {
      const f32x4 gg = *((const f32x4*)gam + lane + 64 * i), bb = *((const f32x4*)bet + lane + 64 * i);
      xr[64 * i] = v[i] * rstd * gg + bb;
    }
#pragma unroll
    for (int i = 0; i < 8; ++i) v[i] = w[i];
    r = rn;
  }
}

#define XB_TMO      128
#define XB_XCNT(j)  (256  + 64 * (j))
#define XB_XSUB(j)  (1280 + 64 * (j))
#define XB_XGEN(j)  (2304 + 64 * (j))
#define XB_TOP      3328
#define XB_TOPGEN   3392
#define XCD_BAR_WORDS 3456
#define XB_SPIN_CAP (1u << 18)
__device__ __forceinline__ unsigned xb_ld(unsigned* p)              { return __hip_atomic_load(p, __ATOMIC_RELAXED, __HIP_MEMORY_SCOPE_AGENT); }
__device__ __forceinline__ unsigned xb_add(unsigned* p, unsigned v) { return __hip_atomic_fetch_add(p, v, __ATOMIC_RELAXED, __HIP_MEMORY_SCOPE_AGENT); }
__device__ __forceinline__ unsigned xb_xcc_id() { return (unsigned)__builtin_amdgcn_s_getreg((3 << 11) | 20) & 0xFu; }
#define XB_SPIN(cond, bar) do { unsigned _sp = 0; while (cond) { __builtin_amdgcn_s_sleep(1); \
    if ((++_sp & 255u) == 0u) { if (xb_ld(&(bar)[XB_TMO])) break; if (_sp > XB_SPIN_CAP) { atomicAdd(&(bar)[XB_TMO], 1u); break; } } } } while (0)
struct XcdBarrier { unsigned* bar; unsigned x; volatile LAS unsigned* st; };
__device__ __forceinline__ XcdBarrier xcd_barrier_post(unsigned* bar, volatile LAS unsigned* st) {
  XcdBarrier b; b.bar = bar; b.x = xb_xcc_id(); b.st = st;
  if (threadIdx.x == 0) (void)xb_add(&bar[XB_XCNT(b.x)], 1u);
  return b;
}
__device__ __forceinline__ void xcd_barrier_complete(unsigned* bar, unsigned x, unsigned& nloc, unsigned& nx) {
  const unsigned G = gridDim.x;
  unsigned sum, cnt, mine, sp = 0u;
  for (;;) {
    sum = 0u; cnt = 0u; mine = 0u;
#pragma unroll
    for (unsigned j = 0; j < 16; ++j) { const unsigned c = xb_ld(&bar[XB_XCNT(j)]); sum += c; cnt += (c > 0u) ? 1u : 0u; mine = (j == x) ? c : mine; }
    if (sum == G) break;
    __builtin_amdgcn_s_sleep(1);
    if ((++sp & 255u) == 0u) { if (xb_ld(&bar[XB_TMO])) break; if (sp > XB_SPIN_CAP) { atomicAdd(&bar[XB_TMO], 1u); break; } }
  }
  nloc = mine > 0u ? mine : 1u; nx = cnt > 0u ? cnt : 1u;
}
__device__ __forceinline__ void xcd_barrier(const XcdBarrier& b) {
  asm volatile("s_waitcnt vmcnt(0)" ::: "memory");
  __syncthreads();
  if (threadIdx.x == 0) {
    unsigned* bar = b.bar;
    __builtin_amdgcn_s_waitcnt(0);
    unsigned nloc = b.st[0], nx = b.st[1];
    if (nloc == 0u) { xcd_barrier_complete(bar, b.x, nloc, nx); b.st[0] = nloc; b.st[1] = nx; }
    const unsigned old = xb_add(&bar[XB_XSUB(b.x)], 1u);
    const unsigned gen = old / nloc;
    if (old + 1u == (gen + 1u) * nloc) {
      __builtin_amdgcn_fence(__ATOMIC_RELEASE, "agent");
      asm volatile("s_waitcnt vmcnt(0)" ::: "memory");
      const unsigned og = xb_add(&bar[XB_TOP], 1u);
      const unsigned tg = og / nx;
      if (og + 1u == (tg + 1u) * nx) xb_add(&bar[XB_TOPGEN], 1u);
      else XB_SPIN(xb_ld(&bar[XB_TOPGEN]) == tg, bar);
      __builtin_amdgcn_fence(__ATOMIC_ACQUIRE, "agent");
      xb_add(&bar[XB_XGEN(b.x)], 1u);
      asm volatile("s_waitcnt vmcnt(0)" ::: "memory");
    } else {
      XB_SPIN(xb_ld(&bar[XB_XGEN(b.x)]) == gen, bar);
      __builtin_amdgcn_fence(__ATOMIC_ACQUIRE, "agent");
      asm volatile("s_waitcnt vmcnt(0)" ::: "memory");
    }
  }
  __syncthreads();
}

__global__ void __launch_bounds__(NTHR, 2) mega(KArgs a) {
  extern __shared__ __attribute__((aligned(16))) unsigned char lds_raw[];
  LAS unsigned char* lds = (LAS unsigned char*)lds_raw;
  const int tid = threadIdx.x, wave = __builtin_amdgcn_readfirstlane(tid >> 6);
  const int G = gridDim.x, gw = blockIdx.x * NWAVE + wave, ngw = G * NWAVE;
  const int lo = a.ph_lo, hi = a.ph_hi;
#define IN(k) (lo <= (k) && (k) < hi)
#define SEAM0() do { if (IN(0) && IN(1)) xcd_barrier(xbar); } while (0)
#define SEAM(k) do { if (IN(k) && IN((k) + 1)) xcd_barrier(xbar); } while (0)
  volatile LAS unsigned* xst = (volatile LAS unsigned*)(lds + 147200);
  XcdBarrier xbar; xbar.bar = (unsigned*)(a.ws + WS_CNT + 16384); xbar.x = 0; xbar.st = xst;
  if (hi - lo > 1) {
    if (tid < 2) xst[tid] = 0u;
    __syncthreads();
    xbar = xcd_barrier_post((unsigned*)(a.ws + WS_CNT + 16384), xst);
  }
  if (a.ph_hi > 1000) cg::this_grid().sync();
  if (IN(0)) {
    p0_rows(a, lds, gw, ngw, fresh_lane());
    transpose_all(a.in[2], DM, INCOLS, NPROJ, (bf16_t*)(a.ws + WS_WINT), lds, gw, ngw, wave, fresh_lane());
  }
  SEAM0();
  if (IN(1)) {
    pg8::Gemm g{(const bf16_t*)(a.ws + WS_H0), (const bf16_t*)(a.ws + WS_WINT), DM, DM, 0};
    pg8::StaticOrder S; S.init(R / 256, NPROJ / 256, G, (int)blockIdx.x);
    pg8::EpiBf16 E{(bf16_t*)(a.ws + WS_P), NPROJ};
    pg8::gemm_phase<pg8::EpiBf16>(lds, g, S, E);
  }
  SEAM(1);
  if (IN(2)) {
    p2_rope(a, gw, ngw, fresh_lane());
    transpose_all(a.in[12], DM, DM, DM, (bf16_t*)a.out, lds, gw, ngw, wave, fresh_lane());
    __syncthreads();
#define PREP_ITEM_OF(L) ((((L) >> 5) * NCH) + ((L) & 31))
    if (wave == 0 && (int)blockIdx.x < 1024) prep_stepA(a, lds, PREP_ITEM_OF((int)blockIdx.x), 0, fresh_lane());
    __syncthreads();
    { int slot = 0;
      for (int L = blockIdx.x; L < 1024; L += G) { prep_item(a, lds, PREP_ITEM_OF(L), slot, L + G < 1024 ? PREP_ITEM_OF(L + G) : -1); slot ^= 1; } }
  }
  SEAM(2);
  if (IN(3)) {
    LAS int* qslot = (LAS int*)(lds + 147000);
    const float p1 = a.in[6][fresh_lane()] * a.in[7][fresh_lane()], p2 = a.in[8][fresh_lane()] * a.in[9][fresh_lane()];
    const float lam = expf(wave_sum(p1)) - expf(wave_sum(p2)) + LAM_INIT;
    if (blockIdx.x < NB * 8) scan_bh(a, lds, (int)blockIdx.x);
    else if (blockIdx.x < 2 * NB * 8) {
      const int pbh = (int)blockIdx.x - NB * 8, pit = pbh * NCH + (NCH - 1);
      if (wave == 0) prep_stepA(a, lds, pit, 0, fresh_lane());
      __syncthreads();
      prep_item(a, lds, pit, 0, -1);
      asm volatile("s_waitcnt vmcnt(0)" ::: "memory");
      __syncthreads();
      if (tid == 0) {
        const float glv = ((const float*)(a.ws + WS_GL))[pit];
        __builtin_amdgcn_fence(__ATOMIC_RELEASE, "agent");
        asm volatile("s_waitcnt vmcnt(0)" ::: "memory");
        __hip_atomic_store((float*)(a.ws + WS_GL + 65536) + 32 * pbh, glv, __ATOMIC_RELAXED, __HIP_MEMORY_SCOPE_AGENT);
        asm volatile("s_waitcnt vmcnt(0)" ::: "memory");
        __hip_atomic_store((unsigned*)(a.ws + WS_CNT + 2048) + 16 * pbh, 1u, __ATOMIC_RELAXED, __HIP_MEMORY_SCOPE_AGENT);
      }
    }
    unsigned* cnt = (unsigned*)(a.ws + WS_CNT);
    for (;;) {
      __syncthreads();
      if (tid == 0) *qslot = (int)atomicAdd(cnt, 1u);
      __syncthreads();
      const int q = *qslot;
      if (q >= NB * 8 * 17) break;
      attn_item(a, lds, q & 31, 16 - (q >> 5), lam);
    }
  }
  SEAM(3);
  if (IN(4)) {
    for (int mu = blockIdx.x; mu < 256; mu += G) outproj_mini(a, mu);
    pg8::Gemm g{(const bf16_t*)(a.ws + WS_P), (const bf16_t*)a.out, NPROJ, DM, 1};
    pg8::StaticOrder S; S.init(NB * SEQ / 256, DM / 256, G, (int)blockIdx.x);
    if (G == 256 && hi - lo > 1) {
      pg8::EpiOutProjLN E{a.in[0], a.out + 0, (bf16_t*)(a.ws + WS_H1B), a.in[13], a.in[14], (unsigned long long*)(a.ws + 3 * MiB + 524288), (unsigned*)(a.ws + WS_CNT + 4096) + 32, &xbar};
      pg8::gemm_phase<pg8::EpiOutProjLN>(lds, g, S, E);
      ln1_side_rows(a, gw, fresh_lane());
    } else {
      pg8::EpiOutProj E{(float*)(a.ws + WS_PRE1), a.in[0]};
      pg8::gemm_phase<pg8::EpiOutProj>(lds, g, S, E);
    }
    transpose_all(a.in[15], DM, DFF, DFF, (bf16_t*)(a.ws + WS_WG), lds, gw, ngw, wave, fresh_lane());
    transpose_all(a.in[16], DM, DFF, DFF, (bf16_t*)(a.ws + WS_WU), lds, gw, ngw, wave, fresh_lane());
  }
  SEAM(4);
  if (!(G == 256 && hi - lo > 1)) {
    if (IN(5)) ln1_rows(a, gw, ngw, fresh_lane());
    SEAM(5);
  }
  if (IN(6)) {
    pg8::Gemm g{(const bf16_t*)(a.ws + WS_H1B), (const bf16_t*)(a.ws + WS_WG), DM, DM, 0};
    pg8::StaticOrder S; S.init(R / 256, DFF / 256, G, (int)blockIdx.x);
    pg8::EpiBf16 E{(bf16_t*)(a.ws + WS_G), DFF};
    pg8::gemm_phase<pg8::EpiBf16>(lds, g, S, E);
  }
  SEAM(6);
  if (IN(7)) {
    pg8::Gemm g{(const bf16_t*)(a.ws + WS_H1B), (const bf16_t*)(a.ws + WS_WU), DM, DM, 0};
    pg8::StaticOrder S; S.init(R / 256, DFF / 256, G, (int)blockIdx.x);
    pg8::EpiUpAct E{(bf16_t*)(a.ws + WS_ACT), (const bf16_t*)(a.ws + WS_G), a.in[17], a.in[18]};
    pg8::gemm_phase<pg8::EpiUpAct>(lds, g, S, E);
    transpose_all(a.in[19], DFF, DM, DM, (bf16_t*)(a.ws + WS_WG), lds, gw, ngw, wave, fresh_lane());
  }
  SEAM(7);
  if (IN(8)) {
    pg8::Gemm g{(const bf16_t*)(a.ws + WS_ACT), (const bf16_t*)(a.ws + WS_WG), DFF, DFF, 1};
    pg8::StaticOrder S; S.init(NB * SEQ / 256, DM / 256, G, (int)blockIdx.x);
    if (G == 256) {
      pg8::EpiDownLN E{a.out, a.in[20], a.in[21], (unsigned long long*)(a.ws + 3 * MiB), (unsigned*)(a.ws + WS_CNT + 4096)};
      pg8::gemm_phase<pg8::EpiDownLN>(lds, g, S, E);
    } else {
      pg8::EpiDown E{a.out};
      pg8::gemm_phase<pg8::EpiDown>(lds, g, S, E);
    }
  }
  if (G != 256) {
    SEAM(8);
    if (IN(9)) ln2_rows(a, gw, ngw, fresh_lane());
  }
}


#ifdef DBG_STAGE
__global__ void dbg_dump(const void* buf, size_t n, int isbf, size_t row_elems, size_t col_lo, size_t col_hi, float* out, size_t nout) {
  for (size_t i = (size_t)blockIdx.x * blockDim.x + threadIdx.x; i < nout; i += (size_t)gridDim.x * blockDim.x) {
    float flag = 0.f;
    for (size_t j = i; j < n; j += nout) {
      const size_t c = j % row_elems;
      if (c < col_lo || c >= col_hi) continue;
      const float v = isbf ? bf2f(((const bf16_t*)buf)[j]) : ((const float*)buf)[j];
      if (!(v == v) || fabsf(v) > 1e30f) flag = 1000.f;
    }
    out[i] = flag;
  }
}
#endif
extern "C" void kernel_launch(void* const* d_in, const int* in_sizes, int n_in, void* d_out, int out_size, void* d_ws, size_t ws_size, hipStream_t stream) {
  static int grid = 0;
  if (grid == 0) {
    int dev = 0, cus = 0, per_cu = 0;
    (void)hipGetDevice(&dev);
    (void)hipDeviceGetAttribute(&cus, hipDeviceAttributeMultiprocessorCount, dev);
    (void)hipFuncSetAttribute((const void*)mega, hipFuncAttributeMaxDynamicSharedMemorySize, LDS_BYTES);
    (void)hipOccupancyMaxActiveBlocksPerMultiprocessor(&per_cu, (const void*)mega, NTHR, LDS_BYTES);
    if (per_cu < 1) per_cu = 1;
    grid = cus * 1;
    if (n_in != 22 || ws_size < WS_END) { fprintf(stderr, "kernel_launch: bad sizes n_in %d ws %zu\n", n_in, ws_size); grid = -1; }
  }
  if (grid < 0) return;
  (void)hipMemsetAsync((char*)d_ws + WS_CNT, 0, 32768, stream);
  KArgs a{};
  for (int i = 0; i < 22; ++i) a.in[i] = (const float*)d_in[i];
  a.out = (float*)d_out; a.ws = (unsigned char*)d_ws; a.ph_lo = 0; a.ph_hi = 10;
#ifndef MK_SPLIT
#define MK_SPLIT 0
#endif
  hipError_t e = hipSuccess;
#if MK_SPLIT
#ifdef DBG_STAGE
  const int nph = DBG_STAGE + 1;
#else
  const int nph = 10;
#endif
  for (int ph = 0; ph < nph; ++ph) { a.ph_lo = ph; a.ph_hi = ph + 1; hipLaunchKernelGGL(mega, dim3(grid), dim3(NTHR), LDS_BYTES, stream, a); }
#ifdef DBG_STAGE
  { unsigned char* w = (unsigned char*)d_ws; float* o = (float*)d_out; const size_t no = (size_t)out_size;
    if (DBG_STAGE == 0) hipLaunchKernelGGL(dbg_dump, dim3(2048), dim3(256), 0, stream, (const void*)(w + WS_H0), (size_t)R * DM, 1, (size_t)DM, (size_t)0, (size_t)DM, o, no);
    if (DBG_STAGE == 1) hipLaunchKernelGGL(dbg_dump, dim3(2048), dim3(256), 0, stream, (const void*)(w + WS_P), (size_t)R * NPROJ, 1, (size_t)NPROJ, (size_t)0, (size_t)NPROJ, o, no);
    if (DBG_STAGE == 2) hipLaunchKernelGGL(dbg_dump, dim3(2048), dim3(256), 0, stream, (const void*)(w + WS_QR), (size_t)(WS_WOUT - WS_QR) / 2 + (size_t)DM * DM, 1, (size_t)64, (size_t)0, (size_t)64, o, no);
    if (DBG_STAGE == 3) hipLaunchKernelGGL(dbg_dump, dim3(2048), dim3(256), 0, stream, (const void*)(w + WS_P), (size_t)R * NPROJ, 1, (size_t)NPROJ, (size_t)DBG_CLO, (size_t)DBG_CHI, o, no);
    if (DBG_STAGE == 4) hipLaunchKernelGGL(dbg_dump, dim3(2048), dim3(256), 0, stream, (const void*)(w + WS_PRE1), (size_t)R * DM, 0, (size_t)DM, (size_t)0, (size_t)DM, o, no);
    if (DBG_STAGE == 5) hipLaunchKernelGGL(dbg_dump, dim3(2048), dim3(256), 0, stream, (const void*)(w + WS_H1B), (size_t)R * DM, 1, (size_t)DM, (size_t)0, (size_t)DM, o, no);
    if (DBG_STAGE == 6) hipLaunchKernelGGL(dbg_dump, dim3(2048), dim3(256), 0, stream, (const void*)(w + WS_G), (size_t)R * DFF, 1, (size_t)DFF, (size_t)0, (size_t)DFF, o, no);
    if (DBG_STAGE == 7) hipLaunchKernelGGL(dbg_dump, dim3(2048), dim3(256), 0, stream, (const void*)(w + WS_ACT), (size_t)R * DFF, 1, (size_t)DFF, (size_t)0, (size_t)DFF, o, no);
  }
#endif
  e = hipGetLastError();
#else
  void* args[] = {&a};
  e = hipLaunchCooperativeKernel((void*)mega, dim3(grid), dim3(NTHR), args, LDS_BYTES, stream);
#endif
  if (e != hipSuccess) fprintf(stderr, "cooperative launch failed: %s (grid %d)\n", hipGetErrorString(e), grid);
}
```

```cpp
#include <hip/hip_runtime.h>
#include <hip/hip_cooperative_groups.h>
#include <cstdio>
#define DBG_CLO 0
#define DBG_CHI 2048
namespace cg = cooperative_groups;

#define LAS __attribute__((address_space(3)))
typedef unsigned short bf16_t;
typedef short bf16x8 __attribute__((ext_vector_type(8)));
typedef short s16x4 __attribute__((ext_vector_type(4)));
typedef float f32x4 __attribute__((ext_vector_type(4)));
typedef float f32x2 __attribute__((ext_vector_type(2)));
typedef unsigned u32x4 __attribute__((ext_vector_type(4)));
typedef unsigned u32x2 __attribute__((ext_vector_type(2)));

constexpr int NB = 4, SEQ = 2048, NMETA = 16, LTOK = SEQ + NMETA, FPAD = 48, LPAD = LTOK + FPAD  , R = NB * LPAD  ;
constexpr int DM = 2048, NPROJ = 7168, INCOLS = 7184, DFF = 5632, NCH = LPAD / 64  ;
constexpr float ALPHA = 1.189207115002721f;
constexpr float LAM_INIT = 0.2f;
constexpr int NTHR = 512, NWAVE = 8;
constexpr int LDS_BYTES = 147456;

constexpr size_t MiB = 1u << 20;
constexpr size_t WS_BA = 0;
constexpr size_t WS_GL = 1 * MiB;
constexpr size_t WS_CNT = 2 * MiB;
constexpr size_t WS_P = 4 * MiB;
constexpr size_t WS_WINT = 120 * MiB;
constexpr size_t WS_H0 = 148 * MiB;
constexpr size_t WS_QR = 120 * MiB;
constexpr size_t WS_KR = WS_QR + (size_t)R * 1024 * 2;
constexpr size_t WS_PREP = 153 * MiB;
constexpr size_t PREP_ITEM = 73728;
constexpr size_t WS_WOUT = 228 * MiB;
constexpr size_t WS_PRE1 = 120 * MiB;
constexpr size_t WS_H1B = 186 * MiB;
constexpr size_t WS_G = 4 * MiB;
constexpr size_t WS_ACT = 95 * MiB;
constexpr size_t WS_WG = 219 * MiB;
constexpr size_t WS_WU = 241 * MiB;
constexpr size_t WS_END = 263 * MiB;
static_assert(WS_KR + (size_t)R * 1024 * 2 <= WS_PREP && WS_PREP + (size_t)NB * 8 * NCH * PREP_ITEM <= WS_WOUT, "ws map");
static_assert(WS_G + (size_t)R * DFF * 2 <= WS_ACT && WS_ACT + (size_t)R * DFF * 2 <= WS_H1B && WS_H1B + (size_t)R * DM * 2 <= WS_WG, "ws map 2");

typedef __bf16 bf16x2v __attribute__((ext_vector_type(2)));
__device__ __forceinline__ unsigned cvt_pk_bf16(float lo, float hi) { const f32x2 v = {lo, hi}; const bf16x2v b = __builtin_convertvector(v, bf16x2v); return __builtin_bit_cast(unsigned, b); }
__device__ __forceinline__ float bf2f(unsigned short b) { return __uint_as_float(((unsigned)b) << 16); }
__device__ __forceinline__ float bflo(unsigned w) { return __uint_as_float(w << 16); }
__device__ __forceinline__ float bfhi(unsigned w) { return __uint_as_float(w & 0xffff0000u); }
__device__ __forceinline__ bf16_t f2bf(float f) { return (bf16_t)(cvt_pk_bf16(f, 0.f) & 0xffffu); }
template <int CTRL> __device__ __forceinline__ float dpp_mov(float x) { return __uint_as_float((unsigned)__builtin_amdgcn_update_dpp(0, (int)__float_as_uint(x), CTRL, 0xF, 0xF, true)); }
__device__ __forceinline__ float wave_sum(float v) {
  v += dpp_mov<0xB1>(v);
  v += dpp_mov<0x4E>(v);
  v += dpp_mov<0x141>(v);
  v += dpp_mov<0x140>(v);
  { auto r = __builtin_amdgcn_permlane16_swap(__float_as_uint(v), __float_as_uint(v), false, false); v = __uint_as_float(r[0]) + __uint_as_float(r[1]); }
  { auto r = __builtin_amdgcn_permlane32_swap(__float_as_uint(v), __float_as_uint(v), false, false); v = __uint_as_float(r[0]) + __uint_as_float(r[1]); }
  return v;
}
__device__ __forceinline__ float siluf(float x) { return x * __builtin_amdgcn_rcpf(1.f + __expf(-x)); }
#define LDS_WAIT() asm volatile("s_waitcnt lgkmcnt(0)" ::: "memory")
#define LBAR() do { asm volatile("s_waitcnt lgkmcnt(0)" ::: "memory"); __builtin_amdgcn_s_barrier(); asm volatile("" ::: "memory"); } while (0)
__device__ __forceinline__ int fresh_lane() { int l; asm volatile("v_and_b32 %0, 63, %1" : "=v"(l) : "v"((int)threadIdx.x)); return l; }

struct KArgs { const float* in[22]; float* out; unsigned char* ws; int ph_lo, ph_hi; };

struct XcdBarrier;
__device__ __forceinline__ void xcd_barrier(const XcdBarrier& b);
namespace pg8 {
constexpr int BM = 256, BK = 64, HALF = 128, HTB = HALF * BK * 2, STAGE_BYTES = 8 * HTB, NXCD = 8, WGM = 4;
__host__ __device__ __forceinline__ int lds_byte(int r, int c) { const int st = (r >> 4) * 2 + (c >> 5), rr = r & 15, cc = c & 31, ob = rr * 64 + cc * 2; return st * 1024 + (ob ^ (((ob >> 9) & 1) << 5)); }
__host__ __device__ __forceinline__ void stage_rc(int b, int& Rr, int& C) { const int st = b / 1024, sb = b % 1024, swz = sb ^ (((sb >> 9) & 1) << 5); Rr = (st >> 1) * 16 + swz / 64; C = (st & 1) * 32 + (swz % 64) / 2; }
__host__ __device__ __forceinline__ int perm32(int rho) { const int n = rho >> 4, i = rho & 15; return 8 * (i >> 2) + 4 * n + (i & 3); }
struct Unit { int pm, pn; };
struct Gemm { const bf16_t* A; const bf16_t* Bt; int lda, K; int rowmap; };
__device__ __forceinline__ size_t a_row0(int rowmap, int pm) { return rowmap ? (size_t)((pm >> 3) * LPAD + 64 + (pm & 7) * 256) : (size_t)pm * 256; }
struct StaticOrder {
  int nM, nN, nwg, G, c;
  __device__ void init(int nM_, int nN_, int G_, int c_) { nM = nM_; nN = nN_; nwg = nM * nN; G = G_; c = c_; }
  __device__ bool next(int i, Unit& u) const {
    const long L = (long)i * G + c; if (L >= nwg) return false;
    int wgid = (int)L; { const int q = nwg / NXCD, r = nwg % NXCD, xcd = wgid % NXCD, off = wgid / NXCD; wgid = (xcd < r ? xcd * (q + 1) : r * (q + 1) + (xcd - r) * q) + off; }
    const int nig = WGM * nN, gid = wgid / nig, fm = gid * WGM, gsz = (nM - fm) < WGM ? (nM - fm) : WGM;
    u.pm = fm + ((wgid % nig) % gsz); u.pn = (wgid % nig) / gsz; return true;
  }
};

template <class Epi>
__device__ __forceinline__ void gemm_phase(LAS unsigned char* lds, const Gemm g, const StaticOrder& S, const Epi& E) {
  const int tid = threadIdx.x, wid = __builtin_amdgcn_readfirstlane(tid >> 6), lane = fresh_lane(), wr = wid >> 2, wc = wid & 3, fr = lane & 15, fq = lane >> 4;
  const int K = g.K, nt = K / BK, lda = g.lda;
  unsigned voffA[2], voffB[2];
#pragma unroll
  for (int i = 0; i < 2; ++i) { int Rr, C; stage_rc(tid * 16 + i * 8192, Rr, C); const int Rb = Epi::PERM ? ((Rr & ~31) + perm32(Rr & 31)) : Rr;
    voffA[i] = (unsigned)(Rr * lda + C) * 2u; voffB[i] = (unsigned)(Rb * K + C) * 2u; }
  const size_t kstep = (size_t)(BK * 2);
  const size_t hstepA = (size_t)HALF * lda * 2, hstepB = (size_t)HALF * K * 2;
  const unsigned ldsw = (unsigned)wid * 1024u;
  const int aoff = lds_byte(wr * 64 + fr, fq * 8), boff = lds_byte(wc * 32 + fr, fq * 8);
#define PG8_SA(b, h) (((b) * 2 + (h)) * HTB)
#define PG8_SB(b, h) ((4 + (b) * 2 + (h)) * HTB)
#define PG8_STAGE(bufoff, gbase, voff) do { _Pragma("unroll") for (int _i = 0; _i < 2; ++_i) \
    __builtin_amdgcn_global_load_lds((const unsigned*)((const char*)(gbase) + (voff)[_i]), (LAS unsigned*)(lds + (bufoff) + ldsw + _i * 8192), 16, 0, 0); } while (0)
#define PG8_LDA(dst, b, h) do { _Pragma("unroll") for (int m = 0; m < 4; ++m) _Pragma("unroll") for (int k = 0; k < 2; ++k) dst[m][k] = *(const LAS bf16x8*)(lds + PG8_SA(b, h) + aoff + m * 2048 + k * 1024); } while (0)
#define PG8_LDB(dst, b, h) do { _Pragma("unroll") for (int n = 0; n < 2; ++n) _Pragma("unroll") for (int k = 0; k < 2; ++k) dst[n][k] = *(const LAS bf16x8*)(lds + PG8_SB(b, h) + boff + n * 2048 + k * 1024); } while (0)
#define PG8_MMA(ai, bj, At, Bt) do { __builtin_amdgcn_s_setprio(1); _Pragma("unroll") for (int m = 0; m < 4; ++m) _Pragma("unroll") for (int n = 0; n < 2; ++n) _Pragma("unroll") for (int k = 0; k < 2; ++k) \
    acc[ai][bj][m][n] = __builtin_amdgcn_mfma_f32_16x16x32_bf16(Bt[n][k], At[m][k], acc[ai][bj][m][n], 0, 0, 0); __builtin_amdgcn_s_setprio(0); } while (0)
#define PG8_WAIT_V(n) asm volatile("s_waitcnt vmcnt(" #n ")" ::: "memory")
#define PG8_WAIT_L(n) asm volatile("s_waitcnt lgkmcnt(" #n ")" ::: "memory")
#define PG8_BAR __builtin_amdgcn_s_barrier()
#define PG8_SCHED __builtin_amdgcn_sched_barrier(0)
  Unit cur, nxt; int ui = 0;
  if (!S.next(0, cur)) return;
  f32x4 acc[2][2][4][2];
#pragma unroll
  for (int a = 0; a < 2; ++a)
#pragma unroll
    for (int b = 0; b < 2; ++b)
#pragma unroll
      for (int m = 0; m < 4; ++m)
#pragma unroll
        for (int n = 0; n < 2; ++n) acc[a][b][m][n] = (f32x4){0.f, 0.f, 0.f, 0.f};
  bf16x8 At[4][2], B0[2][2], B1[2][2];
  const char* cA = (const char*)g.A + a_row0(g.rowmap, cur.pm) * lda * 2; const char* cB = (const char*)g.Bt + (size_t)cur.pn * 2 * hstepB;
  PG8_STAGE(PG8_SB(0, 0), cB, voffB); PG8_STAGE(PG8_SA(0, 0), cA, voffA); PG8_STAGE(PG8_SB(0, 1), cB + hstepB, voffB); PG8_STAGE(PG8_SA(0, 1), cA + hstepA, voffA);
  if (wr == 1) PG8_BAR;
  PG8_WAIT_V(4); PG8_BAR;
  PG8_STAGE(PG8_SB(1, 0), cB + kstep, voffB); PG8_STAGE(PG8_SA(1, 0), cA + kstep, voffA); PG8_STAGE(PG8_SB(1, 1), cB + hstepB + kstep, voffB);
  PG8_WAIT_V(6); PG8_BAR;
  for (;;) {
    const bool has_next = S.next(ui + 1, nxt);
    const char* nA = has_next ? (const char*)g.A + a_row0(g.rowmap, nxt.pm) * lda * 2 : cA; const char* nB = has_next ? (const char*)g.Bt + (size_t)nxt.pn * 2 * hstepB : cB;
    for (int t = 0; t < nt; t += 2) {
      const bool last = (t == nt - 2);
      const char* a1 = cA + (size_t)(t + 1) * kstep;
      const char* a2 = last ? nA : cA + (size_t)(t + 2) * kstep; const char* b2 = last ? nB : cB + (size_t)(t + 2) * kstep;
      const char* a3 = a2 + kstep; const char* b3 = b2 + kstep;
      PG8_LDB(B0, 0, 0); PG8_SCHED; PG8_LDA(At, 0, 0); PG8_STAGE(PG8_SA(1, 1), a1 + hstepA, voffA);
      PG8_WAIT_L(8); PG8_BAR; PG8_WAIT_L(0); PG8_MMA(0, 0, At, B0); PG8_BAR; PG8_SCHED;
      PG8_LDB(B1, 0, 1); PG8_STAGE(PG8_SB(0, 0), b2, voffB);
      PG8_BAR; PG8_WAIT_L(0); PG8_MMA(0, 1, At, B1); PG8_BAR;
      PG8_LDA(At, 0, 1); PG8_STAGE(PG8_SA(0, 0), a2, voffA);
      PG8_BAR; PG8_WAIT_L(0); PG8_MMA(1, 0, At, B0); PG8_BAR; PG8_SCHED;
      PG8_STAGE(PG8_SB(0, 1), b2 + hstepB, voffB);
      PG8_WAIT_V(6); PG8_BAR; PG8_MMA(1, 1, At, B1); PG8_BAR;
      PG8_LDB(B0, 1, 0); PG8_SCHED; PG8_LDA(At, 1, 0); PG8_STAGE(PG8_SA(0, 1), a2 + hstepA, voffA);
      PG8_WAIT_L(8); PG8_BAR; PG8_WAIT_L(0); PG8_MMA(0, 0, At, B0); PG8_BAR; PG8_SCHED;
      PG8_LDB(B1, 1, 1); PG8_STAGE(PG8_SB(1, 0), b3, voffB);
      PG8_BAR; PG8_WAIT_L(0); PG8_MMA(0, 1, At, B1); PG8_BAR;
      PG8_LDA(At, 1, 1); PG8_STAGE(PG8_SA(1, 0), a3, voffA);
      PG8_BAR; PG8_WAIT_L(0); PG8_MMA(1, 0, At, B0); PG8_BAR; PG8_SCHED;
      PG8_STAGE(PG8_SB(1, 1), b3 + hstepB, voffB);
      PG8_WAIT_V(6); PG8_BAR; PG8_MMA(1, 1, At, B1); PG8_BAR;
    }
    if constexpr (!Epi::AFTER_DRAIN) E(acc, cur, wr, wc, fr, fq);
    if (!has_next) break;
#pragma unroll
    for (int a = 0; a < 2; ++a)
#pragma unroll
      for (int b = 0; b < 2; ++b)
#pragma unroll
        for (int m = 0; m < 4; ++m)
#pragma unroll
          for (int n = 0; n < 2; ++n) acc[a][b][m][n] = (f32x4){0.f, 0.f, 0.f, 0.f};
    cur = nxt; cA = nA; cB = nB; ++ui;
  }
  PG8_WAIT_V(0);
  if (wr == 0) PG8_BAR;
  PG8_BAR;
  if constexpr (Epi::AFTER_DRAIN) E.fused(acc, cur, wr, wc, fr, fq, lds);
#undef PG8_SA
#undef PG8_SB
#undef PG8_STAGE
#undef PG8_LDA
#undef PG8_LDB
#undef PG8_MMA
#undef PG8_WAIT_V
#undef PG8_WAIT_L
#undef PG8_BAR
#undef PG8_SCHED
}

struct EpiBf16 {
  static constexpr bool PERM = true, AFTER_DRAIN = false;
  bf16_t* O; int ldc;
  __device__ __forceinline__ void operator()(const f32x4 (&acc)[2][2][4][2], const Unit& u, int wr, int wc, int fr, int fq) const {
    const int row0 = u.pm * BM + wr * 64 + fr, col0 = u.pn * BM + wc * 32 + 8 * fq;
#pragma unroll
    for (int ai = 0; ai < 2; ++ai)
#pragma unroll
      for (int m = 0; m < 4; ++m) { bf16_t* rowp = O + (size_t)(row0 + ai * HALF + m * 16) * ldc + col0;
#pragma unroll
        for (int bj = 0; bj < 2; ++bj) { const f32x4 v0 = acc[ai][bj][m][0], v1 = acc[ai][bj][m][1];
          u32x4 w; w.x = cvt_pk_bf16(v0[0], v0[1]); w.y = cvt_pk_bf16(v0[2], v0[3]); w.z = cvt_pk_bf16(v1[0], v1[1]); w.w = cvt_pk_bf16(v1[2], v1[3]);
          *(u32x4*)(rowp + bj * HALF) = w; } }
  }
};
struct EpiOutProj {
  static constexpr bool PERM = false, AFTER_DRAIN = false;
  float* C; const float* x;
  __device__ __forceinline__ void operator()(const f32x4 (&acc)[2][2][4][2], const Unit& u, int wr, int wc, int fr, int fq) const {
    const int l0 = wr * 64 + fr, col0 = u.pn * BM + wc * 32 + 4 * fq;
    const size_t brow = a_row0(1, u.pm);
#pragma unroll
    for (int ai = 0; ai < 2; ++ai)
#pragma unroll
      for (int m = 0; m < 4; ++m) { const int l = l0 + ai * HALF + m * 16;
        const float* src = x + ((size_t)u.pm * BM + l) * DM + col0;
        float* rowp = C + (brow + l) * DM + col0;
#pragma unroll
        for (int bj = 0; bj < 2; ++bj)
#pragma unroll
          for (int n = 0; n < 2; ++n) { const f32x4 h = *(const f32x4*)(src + bj * HALF + n * 16); *(f32x4*)(rowp + bj * HALF + n * 16) = acc[ai][bj][m][n] + h * ALPHA; } }
  }
};
struct EpiUpAct {
  static constexpr bool PERM = true, AFTER_DRAIN = false;
  bf16_t* O; const bf16_t* G; const float* cw; const float* cb;
  __device__ __forceinline__ void operator()(const f32x4 (&acc)[2][2][4][2], const Unit& u, int wr, int wc, int fr, int fq) const {
    const int row0 = u.pm * BM + wr * 64 + fr, col0 = u.pn * BM + wc * 32 + 8 * fq;
#pragma unroll
    for (int bj = 0; bj < 2; ++bj) { const int c = col0 + bj * HALF;
      float w0[8], w1[8], w2[8], bb[8];
#pragma unroll
      for (int j = 0; j < 8; ++j) { w0[j] = cw[c + j]; w1[j] = cw[DFF + c + j]; w2[j] = cw[2 * DFF + c + j]; bb[j] = cb[c + j]; }
#pragma unroll
      for (int ai = 0; ai < 2; ++ai)
#pragma unroll
        for (int m = 0; m < 4; ++m) { const int r = row0 + ai * HALF + m * 16; const int r1 = r > 0 ? r - 1 : 0, r2 = r > 1 ? r - 2 : 0;
          const u32x4 g0 = *(const u32x4*)(G + (size_t)r * DFF + c), g1 = *(const u32x4*)(G + (size_t)r1 * DFF + c), g2 = *(const u32x4*)(G + (size_t)r2 * DFF + c);
          const f32x4 v0 = acc[ai][bj][m][0], v1 = acc[ai][bj][m][1];
          float up[8] = {v0[0], v0[1], v0[2], v0[3], v1[0], v1[1], v1[2], v1[3]}, o[8];
#pragma unroll
          for (int j = 0; j < 8; ++j) { const unsigned a0 = g0[j >> 1], a1 = g1[j >> 1], a2 = g2[j >> 1];
            const float x0 = (j & 1) ? bfhi(a0) : bflo(a0), x1 = (j & 1) ? bfhi(a1) : bflo(a1), x2 = (j & 1) ? bfhi(a2) : bflo(a2);
            const float hh = w2[j] * x0 + w1[j] * x1 + w0[j] * x2 + bb[j]; o[j] = siluf(hh) * up[j]; }
          u32x4 w; w.x = cvt_pk_bf16(o[0], o[1]); w.y = cvt_pk_bf16(o[2], o[3]); w.z = cvt_pk_bf16(o[4], o[5]); w.w = cvt_pk_bf16(o[6], o[7]);
          *(u32x4*)(O + (size_t)r * DFF + c) = w; } }
  }
};
struct EpiDown {
  static constexpr bool PERM = false, AFTER_DRAIN = false;
  float* C;
  __device__ __forceinline__ void operator()(const f32x4 (&acc)[2][2][4][2], const Unit& u, int wr, int wc, int fr, int fq) const {
    const int row0 = u.pm * BM + wr * 64 + fr, col0 = u.pn * BM + wc * 32 + 4 * fq;
#pragma unroll
    for (int ai = 0; ai < 2; ++ai)
#pragma unroll
      for (int m = 0; m < 4; ++m) { float* rowp = C + (size_t)(row0 + ai * HALF + m * 16) * DM + col0;
#pragma unroll
        for (int bj = 0; bj < 2; ++bj)
#pragma unroll
          for (int n = 0; n < 2; ++n) { const f32x4 h = *(const f32x4*)(rowp + bj * HALF + n * 16); *(f32x4*)(rowp + bj * HALF + n * 16) = acc[ai][bj][m][n] + h * ALPHA; } }
  }
};

struct EpiDownLN {
  static constexpr bool PERM = false, AFTER_DRAIN = true;
  float* C; const float* gam; const float* bet; unsigned long long* slots; unsigned* cnt;
  __device__ __forceinline__ void fused(f32x4 (&acc)[2][2][4][2], const Unit& u, int wr, int wc, int fr, int fq, LAS unsigned char* lds) const {
    const int tid = threadIdx.x;
    const int row0 = u.pm * BM + wr * 64 + fr, col0 = u.pn * BM + wc * 32 + 4 * fq;
    LAS f32x2* part = (LAS f32x2*)lds;
    LAS f32x2* stat = (LAS f32x2*)(lds + 8192);
#pragma unroll
    for (int ai = 0; ai < 2; ++ai)
#pragma unroll
      for (int m = 0; m < 4; ++m) { const float* rowp = C + (size_t)(row0 + ai * HALF + m * 16) * DM + col0;
        float s1 = 0.f, s2 = 0.f;
#pragma unroll
        for (int bj = 0; bj < 2; ++bj)
#pragma unroll
          for (int n = 0; n < 2; ++n) { const f32x4 h = *(const f32x4*)(rowp + bj * HALF + n * 16); const f32x4 v = acc[ai][bj][m][n] + h * ALPHA; acc[ai][bj][m][n] = v;
            s1 += (v[0] + v[1]) + (v[2] + v[3]); s2 += (v[0] * v[0] + v[1] * v[1]) + (v[2] * v[2] + v[3] * v[3]); }
        s1 += __shfl_xor(s1, 16); s1 += __shfl_xor(s1, 32); s2 += __shfl_xor(s2, 16); s2 += __shfl_xor(s2, 32);
        if (fq == 0) part[(ai * HALF + wr * 64 + m * 16 + fr) * 4 + wc] = (f32x2){s1, s2};
      }
    __syncthreads();
    if (tid < 256) {
      const f32x2 p0 = part[tid * 4 + 0], p1 = part[tid * 4 + 1], p2 = part[tid * 4 + 2], p3 = part[tid * 4 + 3];
      const float t1 = (p0.x + p1.x) + (p2.x + p3.x), t2 = (p0.y + p1.y) + (p2.y + p3.y);
      __hip_atomic_store(slots + ((size_t)(u.pm * BM + tid) * 8 + u.pn), ((unsigned long long)__float_as_uint(t2) << 32) | __float_as_uint(t1), __ATOMIC_RELAXED, __HIP_MEMORY_SCOPE_AGENT);
    }
    asm volatile("s_waitcnt vmcnt(0)" ::: "memory");
    __syncthreads();
    if (tid == 0) {
      __hip_atomic_fetch_add(cnt + 64 * u.pm, 1u, __ATOMIC_RELAXED, __HIP_MEMORY_SCOPE_AGENT);
      unsigned sp = 0;
      while (__hip_atomic_load(cnt + 64 * u.pm, __ATOMIC_RELAXED, __HIP_MEMORY_SCOPE_AGENT) < 8u) { __builtin_amdgcn_s_sleep(1); if (++sp > (1u << 22)) break; }
      __builtin_amdgcn_fence(__ATOMIC_ACQUIRE, "agent");
      asm volatile("s_waitcnt vmcnt(0)" ::: "memory");
    }
    __syncthreads();
    if (tid < 256) {
      float t1 = 0.f, t2 = 0.f;
#pragma unroll
      for (int t = 0; t < 8; ++t) { const unsigned long long w = __hip_atomic_load(slots + ((size_t)(u.pm * BM + tid) * 8 + t), __ATOMIC_RELAXED, __HIP_MEMORY_SCOPE_AGENT);
        t1 += __uint_as_float((unsigned)w); t2 += __uint_as_float((unsigned)(w >> 32)); }
      const float mean = t1 * (1.f / DM);
      const float var = fmaxf(t2 * (1.f / DM) - mean * mean, 0.f);
      stat[tid] = (f32x2){mean, rsqrtf(var + 1e-5f)};
    }
    __syncthreads();
    f32x4 gv[2][2], bv[2][2];
#pragma unroll
    for (int bj = 0; bj < 2; ++bj)
#pragma unroll
      for (int n = 0; n < 2; ++n) { gv[bj][n] = *(const f32x4*)(gam + col0 + bj * HALF + n * 16); bv[bj][n] = *(const f32x4*)(bet + col0 + bj * HALF + n * 16); }
#pragma unroll
    for (int ai = 0; ai < 2; ++ai)
#pragma unroll
      for (int m = 0; m < 4; ++m) { const f32x2 st = stat[ai * HALF + wr * 64 + m * 16 + fr]; float* rowp = C + (size_t)(row0 + ai * HALF + m * 16) * DM + col0;
#pragma unroll
        for (int bj = 0; bj < 2; ++bj)
#pragma unroll
          for (int n = 0; n < 2; ++n) *(f32x4*)(rowp + bj * HALF + n * 16) = (acc[ai][bj][m][n] - st.x) * st.y * gv[bj][n] + bv[bj][n]; }
    __syncthreads();
  }
};
struct EpiOutProjLN {
  static constexpr bool PERM = false, AFTER_DRAIN = true;
  const float* x; float* hf; bf16_t* hb; const float* gam; const float* bet; unsigned long long* slots; unsigned* cnt; const XcdBarrier* xb;
  __device__ __forceinline__ void fused(f32x4 (&acc)[2][2][4][2], const Unit& u, int wr, int wc, int fr, int fq, LAS unsigned char* lds) const {
    const int tid = threadIdx.x;
    const int l0 = wr * 64 + fr, col0 = u.pn * BM + wc * 32 + 4 * fq;
    const size_t brow = a_row0(1, u.pm);
    LAS f32x2* part = (LAS f32x2*)lds;
    LAS f32x2* stat = (LAS f32x2*)(lds + 8192);
#pragma unroll
    for (int ai = 0; ai < 2; ++ai)
#pragma unroll
      for (int m = 0; m < 4; ++m) { const float* rowp = x + ((size_t)u.pm * BM + l0 + ai * HALF + m * 16) * DM + col0;
        float s1 = 0.f, s2 = 0.f;
#pragma unroll
        for (int bj = 0; bj < 2; ++bj)
#pragma unroll
          for (int n = 0; n < 2; ++n) { const f32x4 h = *(const f32x4*)(rowp + bj * HALF + n * 16); const f32x4 v = acc[ai][bj][m][n] + h * ALPHA; acc[ai][bj][m][n] = v;
            s1 += (v[0] + v[1]) + (v[2] + v[3]); s2 += (v[0] * v[0] + v[1] * v[1]) + (v[2] * v[2] + v[3] * v[3]); }
        s1 += __shfl_xor(s1, 16); s1 += __shfl_xor(s1, 32); s2 += __shfl_xor(s2, 16); s2 += __shfl_xor(s2, 32);
        if (fq == 0) part[(ai * HALF + l0 + m * 16) * 4 + wc] = (f32x2){s1, s2};
      }
    __syncthreads();
    if (tid < 256) {
      const f32x2 p0 = part[tid * 4 + 0], p1 = part[tid * 4 + 1], p2 = part[tid * 4 + 2], p3 = part[tid * 4 + 3];
      const float t1 = (p0.x + p1.x) + (p2.x + p3.x), t2 = (p0.y + p1.y) + (p2.y + p3.y);
      __hip_atomic_store(slots + ((size_t)(u.pm * BM + tid) * 8 + u.pn), ((unsigned long long)__float_as_uint(t2) << 32) | __float_as_uint(t1), __ATOMIC_RELAXED, __HIP_MEMORY_SCOPE_AGENT);
    }
    asm volatile("s_waitcnt vmcnt(0)" ::: "memory");
    __syncthreads();
    if (tid == 0) {
      __hip_atomic_fetch_add(cnt + 64 * u.pm, 1u, __ATOMIC_RELAXED, __HIP_MEMORY_SCOPE_AGENT);
      unsigned sp = 0;
      while (__hip_atomic_load(cnt + 64 * u.pm, __ATOMIC_RELAXED, __HIP_MEMORY_SCOPE_AGENT) < 8u) { __builtin_amdgcn_s_sleep(1); if (++sp > (1u << 22)) break; }
      __builtin_amdgcn_fence(__ATOMIC_ACQUIRE, "agent");
      asm volatile("s_waitcnt vmcnt(0)" ::: "memory");
    }
    __syncthreads();
    if (tid < 256) {
      float t1 = 0.f, t2 = 0.f;
#pragma unroll
      for (int t = 0; t < 8; ++t) { const unsigned long long w = __hip_atomic_load(slots + ((size_t)(u.pm * BM + tid) * 8 + t), __ATOMIC_RELAXED, __HIP_MEMORY_SCOPE_AGENT);
        t1 += __uint_as_float((unsigned)w); t2 += __uint_as_float((unsigned)(w >> 32)); }
      const float mean = t1 * (1.f / DM);
      const float var = fmaxf(t2 * (1.f / DM) - mean * mean, 0.f);
      stat[tid] = (f32x2){mean, rsqrtf(var + 1e-5f)};
    }
    __syncthreads();
    xcd_barrier(*xb);
    f32x4 gv[2][2], bv[2][2];
#pragma unroll
    for (int bj = 0; bj < 2; ++bj)
#pragma unroll
      for (int n = 0; n < 2; ++n) { gv[bj][n] = *(const f32x4*)(gam + col0 + bj * HALF + n * 16); bv[bj][n] = *(const f32x4*)(bet + col0 + bj * HALF + n * 16); }
#pragma unroll
    for (int ai = 0; ai < 2; ++ai)
#pragma unroll
      for (int m = 0; m < 4; ++m) { const int l = l0 + ai * HALF + m * 16; const f32x2 st = stat[l];
        float* fo = hf + ((size_t)u.pm * BM + l) * DM + col0; bf16_t* bo = hb + (brow + l) * DM + col0;
#pragma unroll
        for (int bj = 0; bj < 2; ++bj)
#pragma unroll
          for (int n = 0; n < 2; ++n) { const f32x4 y = (acc[ai][bj][m][n] - st.x) * st.y * gv[bj][n] + bv[bj][n];
            *(f32x4*)(fo + bj * HALF + n * 16) = y; *(u32x2*)(bo + bj * HALF + n * 16) = (u32x2){cvt_pk_bf16(y[0], y[1]), cvt_pk_bf16(y[2], y[3])}; } }
    __syncthreads();
  }
};
}

__device__ __forceinline__ void transpose_item(const float* W, int K, int ldw, int N, bf16_t* WT, LAS float* scr, int item, int lane) {
  const int nblk = N / 64, kb = item / nblk, nb = item % nblk, k0 = 64 * kb, n0 = 64 * nb;
  float tv[64];
#pragma unroll
  for (int i = 0; i < 64; ++i) tv[i] = __builtin_nontemporal_load(&W[(size_t)(k0 + i) * ldw + n0 + lane]);
#pragma unroll
  for (int i = 0; i < 64; ++i) scr[i * 65 + lane] = tv[i];
  LDS_WAIT();
  const int c = lane & 7;
#pragma unroll
  for (int j = 0; j < 8; ++j) { const int n = (lane >> 3) + 8 * j; const LAS float* s = scr + (8 * c) * 65 + n;
    u32x4 o; o.x = cvt_pk_bf16(s[0 * 65], s[1 * 65]); o.y = cvt_pk_bf16(s[2 * 65], s[3 * 65]); o.z = cvt_pk_bf16(s[4 * 65], s[5 * 65]); o.w = cvt_pk_bf16(s[6 * 65], s[7 * 65]);
    *(u32x4*)(WT + (size_t)(n0 + n) * K + k0 + 8 * c) = o; }
  LDS_WAIT();
}
__device__ __forceinline__ void transpose_all(const float* W, int K, int ldw, int N, bf16_t* WT, LAS unsigned char* lds, int gw, int ngw, int wave, int lane) {
  LAS float* scr = (LAS float*)(lds + wave * 16640);
  const int nitems = (K / 64) * (N / 64);
  for (int it = gw; it < nitems; it += ngw) transpose_item(W, K, ldw, N, WT, scr, it, lane);
}

__device__ __forceinline__ void transpose_dyn(unsigned* cnt, const float* W1, bf16_t* WT1, const float* W2, bf16_t* WT2, int K, int ldw, int N, LAS unsigned char* lds, int wave, int lane) {
  LAS float* scr = (LAS float*)(lds + wave * 16640);
  const int n1 = (K / 64) * (N / 64), total = W2 ? 2 * n1 : n1;
  for (;;) {
    int it0 = 0;
    if (lane == 0) it0 = (int)atomicAdd(cnt, 8u);
    it0 = __builtin_amdgcn_readfirstlane(it0);
    if (it0 >= total) break;
    for (int it = it0; it < it0 + 8 && it < total; ++it) {
      if (it < n1) transpose_item(W1, K, ldw, N, WT1, scr, it, lane); else transpose_item(W2, K, ldw, N, WT2, scr, it - n1, lane);
    }
  }
}

__device__ __forceinline__ void p0_rows(const KArgs& a, LAS unsigned char* lds, int gw, int ngw, int lane) {
  const float* x = a.in[0]; const float* meta = a.in[1]; const float* win = a.in[2];
  bf16_t* H0 = (bf16_t*)(a.ws + WS_H0); float* BA = (float*)(a.ws + WS_BA);
  LAS float* wT = (LAS float*)lds;
  for (int k = threadIdx.x; k < DM; k += NTHR) {
    const float* wr = win + (size_t)k * INCOLS + NPROJ;
#pragma unroll
    for (int q = 0; q < 4; ++q) { const f32x4 w = *(const f32x4*)(wr + 4 * q);
#pragma unroll
      for (int e = 0; e < 4; ++e) wT[(4 * q + e) * DM + k] = w[e]; }
  }
  __syncthreads();
  for (int r = gw; r < R; r += ngw) {
    const int b = r / LPAD, p = r - b * LPAD, t = p - FPAD;
    u32x2* orow = (u32x2*)(H0 + (size_t)r * DM);
    if (t < 0) {
#pragma unroll
      for (int i = 0; i < 8; ++i) orow[lane + 64 * i] = (u32x2){0u, 0u};
      if (lane < 16) BA[(size_t)r * 16 + lane] = 0.f;
      continue;
    }
    const float* src = t < NMETA ? meta + (size_t)t * DM : x + ((size_t)b * SEQ + (t - NMETA)) * DM;
    f32x4 accv[16];
#pragma unroll
    for (int j = 0; j < 16; ++j) accv[j] = (f32x4){0.f, 0.f, 0.f, 0.f};
    f32x4 v[8];
#pragma unroll
    for (int i = 0; i < 8; ++i) v[i] = *(const f32x4*)(src + 4 * lane + 256 * i);
#pragma unroll
    for (int i = 0; i < 8; ++i) {
      orow[lane + 64 * i] = (u32x2){cvt_pk_bf16(v[i][0], v[i][1]), cvt_pk_bf16(v[i][2], v[i][3])};
#pragma unroll
      for (int j = 0; j < 16; ++j) { const f32x4 w = *(const LAS f32x4*)(wT + j * DM + 4 * lane + 256 * i);
        accv[j] = accv[j] + v[i] * w; }
    }
    float acc[16];
#pragma unroll
    for (int j = 0; j < 16; ++j) acc[j] = (accv[j][0] + accv[j][1]) + (accv[j][2] + accv[j][3]);
#pragma unroll
    for (int j = 0; j < 16; ++j) acc[j] = wave_sum(acc[j]);
    float mine = 0.f;
#pragma unroll
    for (int j = 0; j < 16; ++j) mine = (lane == j) ? acc[j] : mine;
    if (lane < 16) BA[(size_t)r * 16 + lane] = mine;
  }
  __syncthreads();
}

__device__ const double ROPE_INVF[32] = {1.0, 0.7498942093324559, 0.5623413251903491, 0.4216965034285822, 0.31622776601683794, 0.23713737056616552, 0.1778279410038923, 0.1333521432163324, 0.1, 0.07498942093324558, 0.05623413251903491, 0.042169650342858224, 0.03162277660168379, 0.023713737056616554, 0.01778279410038923, 0.01333521432163324, 0.01, 0.007498942093324558, 0.005623413251903491, 0.004216965034285823, 0.0031622776601683794, 0.0023713737056616554, 0.0017782794100389228, 0.001333521432163324, 0.001, 0.0007498942093324559, 0.0005623413251903491, 0.00042169650342858224, 0.00031622776601683794, 0.00023713737056616554, 0.00017782794100389227, 0.0001333521432163324};
constexpr float QSCALE = 0.18033688011112042f;
__device__ __forceinline__ void sincos_red(double ang, float& s, float& c) {
  const double n = __builtin_rint(ang * 0.15915494309189535);
  const float r = (float)__builtin_fma(-n, 6.283185307179586, ang);
  s = __sinf(r); c = __cosf(r);
}
__device__ __forceinline__ void p2_rope(const KArgs& a, int gw, int ngw, int lane) {
  const bf16_t* P = (const bf16_t*)(a.ws + WS_P);
  bf16_t* QR = (bf16_t*)(a.ws + WS_QR); bf16_t* KR = (bf16_t*)(a.ws + WS_KR);
  const int ip = lane & 15;
  const double f0 = ROPE_INVF[2 * ip], f1 = ROPE_INVF[2 * ip + 1];
  for (int r = gw; r < R; r += ngw) {
    const int p = r % LPAD, t = p - FPAD;
    float s0, c0, s1, c1; sincos_red((double)t * f0, s0, c0); sincos_red((double)t * f1, s1, c1);
#pragma unroll
    for (int j = 0; j < 8; ++j) {
      const int grp = (lane >> 4) + 4 * j;
      const bf16_t* src = P + (size_t)r * NPROJ + grp * 64 + 2 * ip;
      const unsigned lo = *(const unsigned*)src, hi = *(const unsigned*)(src + 32);
      const float x1a = bflo(lo), x1b = bfhi(lo), x2a = bflo(hi), x2b = bfhi(hi);
      const float sc = grp < 16 ? QSCALE : 1.f;
      const float o1a = (x1a * c0 - x2a * s0) * sc, o1b = (x1b * c1 - x2b * s1) * sc, o2a = (x2a * c0 + x1a * s0) * sc, o2b = (x2b * c1 + x1b * s1) * sc;
      bf16_t* dst = (grp < 16 ? QR + (size_t)r * 1024 + grp * 64 : KR + (size_t)r * 1024 + (grp - 16) * 64) + 2 * ip;
      *(unsigned*)dst = cvt_pk_bf16(o1a, o1b); *(unsigned*)(dst + 32) = cvt_pk_bf16(o2a, o2b);
    }
  }
}

__device__ __forceinline__ int perm_k32(int k) { return 8 * ((k & 15) >> 2) + 4 * (k >> 4) + (k & 3); }
constexpr int PR_QN = 0, PR_KN = 17408, PR_RHS = 34816, PR_MT = 100352, PR_GC = 116736;
__device__ __forceinline__ void prep_stepA(const KArgs& a, LAS unsigned char* lds, int item, int slot, int lane) {
  const int bh = item / NCH, ch = item - bh * NCH, b = bh >> 3, h = bh & 7;
  const int r0 = b * LPAD + ch * 64;
  const float* BA = (const float*)(a.ws + WS_BA);
  LAS float* gcs = (LAS float*)(lds + PR_GC + slot * 512); LAS float* betas = gcs + 64;
  const int t = ch * 64 + lane - FPAD;
  float beta = 0.f, gg = 0.f;
  if (t >= 0) {
    const float br = BA[(size_t)(r0 + lane) * 16 + h], ar = BA[(size_t)(r0 + lane) * 16 + 8 + h];
    beta = 1.f / (1.f + expf(-br));
    const float z = ar + a.in[5][h];
    const float sp = z > 20.f ? z : log1pf(expf(z));
    gg = -expf(a.in[4][h]) * sp;
  }
  float v = gg;
#pragma unroll
  for (int o = 1; o < 64; o <<= 1) { const float u = __shfl_up(v, o); if (lane >= o) v += u; }
  gcs[lane] = v; betas[lane] = beta;
  if (lane == 63) ((float*)(a.ws + WS_GL))[item] = expf(v);
}
__device__ __forceinline__ void prep_item(const KArgs& a, LAS unsigned char* lds, int item, int slot, int next_item) {
  const int tid = threadIdx.x, lane = fresh_lane(), wave = __builtin_amdgcn_readfirstlane(tid >> 6);
  const int bh = item / NCH, ch = item - bh * NCH, b = bh >> 3, h = bh & 7;
  const int r0 = b * LPAD + ch * 64;
  const bf16_t* P = (const bf16_t*)(a.ws + WS_P);
  unsigned char* ib = a.ws + WS_PREP + (size_t)item * PREP_ITEM;
  bf16_t* gW = (bf16_t*)ib; bf16_t* gQD = (bf16_t*)(ib + 16384); bf16_t* gKDT = (bf16_t*)(ib + 32768); bf16_t* gUT = (bf16_t*)(ib + 49152); bf16_t* gQK = (bf16_t*)(ib + 65536);
  LAS float* gcs = (LAS float*)(lds + PR_GC + slot * 512); LAS float* betas = gcs + 64;
  LAS float* rhs = (LAS float*)(lds + PR_RHS); LAS float* MT = (LAS float*)(lds + PR_MT);
  float kdv[16];
  {
    const int i = tid >> 3, seg = tid & 7, d0 = seg * 16;
    const float gci = gcs[i], gcl = gcs[63], bi = betas[i];
    const float eg = expf(gci), egl = expf(gcl - gci);
    float val[3][16];
#pragma unroll
    for (int T = 0; T < 3; ++T) {
      const int ccol = T * 1024 + h * 128 + d0;
      float acc[16];
#pragma unroll
      for (int e = 0; e < 16; ++e) acc[e] = 0.f;
      u32x4 xq[4][2]; f32x4 cq[4][4];
#pragma unroll
      for (int j = 0; j < 4; ++j) {
        const int pr = ch * 64 + i - 3 + j;
        const bf16_t* src = P + (size_t)(pr >= 0 ? r0 + i - 3 + j : r0 + i) * NPROJ + 3072 + ccol;
        xq[j][0] = *(const u32x4*)src; xq[j][1] = *(const u32x4*)(src + 8);
        const float* cw = a.in[3] + (size_t)j * 3072 + ccol;
#pragma unroll
        for (int q = 0; q < 4; ++q) cq[j][q] = *(const f32x4*)(cw + 4 * q);
      }
      __builtin_amdgcn_sched_barrier(0);
#pragma unroll
      for (int j = 0; j < 4; ++j) {
        const float vj = (ch * 64 + i - 3 + j) >= 0 ? 1.f : 0.f;
#pragma unroll
        for (int e = 0; e < 4; ++e) {
          acc[2 * e] += bflo(xq[j][0][e]) * (cq[j][e >> 1][2 * (e & 1)] * vj); acc[2 * e + 1] += bfhi(xq[j][0][e]) * (cq[j][e >> 1][2 * (e & 1) + 1] * vj);
          acc[8 + 2 * e] += bflo(xq[j][1][e]) * (cq[j][2 + (e >> 1)][2 * (e & 1)] * vj); acc[8 + 2 * e + 1] += bfhi(xq[j][1][e]) * (cq[j][2 + (e >> 1)][2 * (e & 1) + 1] * vj);
        }
      }
      float ss = 0.f;
#pragma unroll
      for (int e = 0; e < 16; ++e) { acc[e] = siluf(acc[e]); ss += acc[e] * acc[e]; }
      if (T < 2) {
        ss += __shfl_xor(ss, 1); ss += __shfl_xor(ss, 2); ss += __shfl_xor(ss, 4);
        const float rn = rsqrtf(ss + 1e-6f) * (T == 0 ? 0.08838834764831845f : 1.f);
#pragma unroll
        for (int e = 0; e < 16; ++e) acc[e] *= rn;
      }
#pragma unroll
      for (int e = 0; e < 16; ++e) val[T][e] = acc[e];
    }
    {
      u32x4 w0, w1;
      w0.x = cvt_pk_bf16(val[0][0], val[0][1]); w0.y = cvt_pk_bf16(val[0][2], val[0][3]); w0.z = cvt_pk_bf16(val[0][4], val[0][5]); w0.w = cvt_pk_bf16(val[0][6], val[0][7]);
      w1.x = cvt_pk_bf16(val[0][8], val[0][9]); w1.y = cvt_pk_bf16(val[0][10], val[0][11]); w1.z = cvt_pk_bf16(val[0][12], val[0][13]); w1.w = cvt_pk_bf16(val[0][14], val[0][15]);
      *(LAS u32x4*)(lds + PR_QN + i * 272 + d0 * 2) = w0; *(LAS u32x4*)(lds + PR_QN + i * 272 + d0 * 2 + 16) = w1;
      w0.x = cvt_pk_bf16(val[1][0], val[1][1]); w0.y = cvt_pk_bf16(val[1][2], val[1][3]); w0.z = cvt_pk_bf16(val[1][4], val[1][5]); w0.w = cvt_pk_bf16(val[1][6], val[1][7]);
      w1.x = cvt_pk_bf16(val[1][8], val[1][9]); w1.y = cvt_pk_bf16(val[1][10], val[1][11]); w1.z = cvt_pk_bf16(val[1][12], val[1][13]); w1.w = cvt_pk_bf16(val[1][14], val[1][15]);
      *(LAS u32x4*)(lds + PR_KN + i * 272 + d0 * 2) = w0; *(LAS u32x4*)(lds + PR_KN + i * 272 + d0 * 2 + 16) = w1;
    }
    {
      const int blk = 32 * (seg >> 1), h1 = seg & 1;
#pragma unroll
      for (int g4 = 0; g4 < 4; ++g4) {
        u32x2 w; w.x = cvt_pk_bf16(val[0][4 * g4] * eg, val[0][4 * g4 + 1] * eg); w.y = cvt_pk_bf16(val[0][4 * g4 + 2] * eg, val[0][4 * g4 + 3] * eg);
        *(u32x2*)(gQD + (size_t)i * 128 + blk + 8 * g4 + 4 * h1) = w;
      }
    }
#pragma unroll
    for (int e = 0; e < 16; ++e) kdv[e] = val[1][e] * egl;
#pragma unroll
    for (int q4 = 0; q4 < 4; ++q4) {
      *(LAS f32x4*)(rhs + i * 256 + d0 + 4 * q4) = (f32x4){val[2][4 * q4] * bi, val[2][4 * q4 + 1] * bi, val[2][4 * q4 + 2] * bi, val[2][4 * q4 + 3] * bi};
      const float kb = bi * eg;
      *(LAS f32x4*)(rhs + i * 256 + 128 + d0 + 4 * q4) = (f32x4){val[1][4 * q4] * kb, val[1][4 * q4 + 1] * kb, val[1][4 * q4 + 2] * kb, val[1][4 * q4 + 3] * kb};
    }
  }
  LBAR();
  {
    const int it = wave >> 1, fr = lane & 15, g = lane >> 4;
#pragma unroll
    for (int s2 = 0; s2 < 2; ++s2) {
      const int st = 2 * (wave & 1) + s2;
      f32x4 am = {0.f, 0.f, 0.f, 0.f}, aq = {0.f, 0.f, 0.f, 0.f};
      if (st <= it) {
#pragma unroll
        for (int ks = 0; ks < 4; ++ks) {
          const bf16x8 ak = *(const LAS bf16x8*)(lds + PR_KN + (it * 16 + fr) * 272 + (32 * ks + 8 * g) * 2);
          const bf16x8 aqf = *(const LAS bf16x8*)(lds + PR_QN + (it * 16 + fr) * 272 + (32 * ks + 8 * g) * 2);
          const bf16x8 bk = *(const LAS bf16x8*)(lds + PR_KN + (st * 16 + fr) * 272 + (32 * ks + 8 * g) * 2);
          am = __builtin_amdgcn_mfma_f32_16x16x32_bf16(ak, bk, am, 0, 0, 0);
          aq = __builtin_amdgcn_mfma_f32_16x16x32_bf16(aqf, bk, aq, 0, 0, 0);
        }
      }
      const int s = st * 16 + fr; const float gs = gcs[s];
      f32x4 mo;
#pragma unroll
      for (int rg = 0; rg < 4; ++rg) {
        const int i = it * 16 + 4 * g + rg;
        const float dec = i >= s ? expf(gcs[i] - gs) : 0.f;
        mo[rg] = i > s ? betas[i] * am[rg] * dec : 0.f;
        gQK[(size_t)i * 64 + 32 * (s >> 5) + perm_k32(s & 31)] = f2bf(aq[rg] * dec);
      }
      *(LAS f32x4*)(MT + s * 64 + it * 16 + 4 * g) = mo;
    }
  }
  LBAR();
  {
    const int i = tid >> 3, d0 = (tid & 7) * 16, pi = 32 * (i >> 5) + perm_k32(i & 31);
#pragma unroll
    for (int e = 0; e < 16; ++e) *(LAS bf16_t*)(lds + PR_QN + ((d0 + e) * 64 + pi) * 2) = f2bf(kdv[e]);
  }
  LBAR();
  if (tid >= 256) {
#pragma unroll
    for (int q = 0; q < 4; ++q) { const int c = (tid - 256) + 256 * q; *(u32x4*)((unsigned char*)gKDT + (size_t)c * 16) = *(const LAS u32x4*)(lds + PR_QN + c * 16); }
  }
  if (wave == 4 && next_item >= 0) prep_stepA(a, lds, next_item, slot ^ 1, lane);
  if (tid < 256) {
    f32x4 Xv[16];
#define X(i) Xv[(i) >> 2][(i) & 3]
#pragma unroll
    for (int i = 0; i < 64; ++i) X(i) = rhs[i * 256 + tid];
    f32x4 cb0[8], cb1[8];
#define SOLVE_LOAD(buf, s, lo4) do { _Pragma("unroll") for (int q_ = 0; q_ < 8; ++q_) if ((lo4) + 4 * q_ + 3 > (s)) buf[q_] = *(const LAS f32x4*)(MT + (s) * 64 + (lo4) + 4 * q_); } while (0)
#define SOLVE_APPLY(buf, s, lo4) do { const float xs_ = X(s); const f32x4 xs4_ = {xs_, xs_, xs_, xs_}; _Pragma("unroll") for (int q_ = 0; q_ < 8; ++q_) if ((lo4) + 4 * q_ + 3 > (s)) Xv[((lo4) >> 2) + q_] = Xv[((lo4) >> 2) + q_] - buf[q_] * xs4_; } while (0)
    SOLVE_LOAD(cb0, 0, 0);
#pragma unroll
    for (int s = 0; s < 32; s += 2) {
      SOLVE_LOAD(cb1, s + 1, 0); __builtin_amdgcn_sched_barrier(0);
      SOLVE_APPLY(cb0, s, 0);
      if (s + 2 < 32) SOLVE_LOAD(cb0, s + 2, 0); __builtin_amdgcn_sched_barrier(0);
      SOLVE_APPLY(cb1, s + 1, 0);
    }
    SOLVE_LOAD(cb0, 0, 32);
#pragma unroll
    for (int s = 0; s < 32; s += 2) {
      SOLVE_LOAD(cb1, s + 1, 32); __builtin_amdgcn_sched_barrier(0);
      SOLVE_APPLY(cb0, s, 32);
      if (s + 2 < 32) SOLVE_LOAD(cb0, s + 2, 32); __builtin_amdgcn_sched_barrier(0);
      SOLVE_APPLY(cb1, s + 1, 32);
    }
    SOLVE_LOAD(cb0, 32, 32);
#pragma unroll
    for (int s = 32; s < 64; s += 2) {
      SOLVE_LOAD(cb1, s + 1 < 63 ? s + 1 : 62, 32); __builtin_amdgcn_sched_barrier(0);
      SOLVE_APPLY(cb0, s, 32);
      if (s + 2 < 64) SOLVE_LOAD(cb0, s + 2, 32); __builtin_amdgcn_sched_barrier(0);
      if (s + 1 < 63) SOLVE_APPLY(cb1, s + 1, 32);
    }
#undef SOLVE_LOAD
#undef SOLVE_APPLY
    if (tid < 128) {
      const int uw = tid >> 5, uvt = (tid >> 4) & 1, ufr = tid & 15;
#pragma unroll
      for (int ct = 0; ct < 4; ++ct)
#pragma unroll
        for (int g4 = 0; g4 < 4; ++g4) {
          u32x2 w; w.x = cvt_pk_bf16(X(16 * ct + 4 * g4), X(16 * ct + 4 * g4 + 1)); w.y = cvt_pk_bf16(X(16 * ct + 4 * g4 + 2), X(16 * ct + 4 * g4 + 3));
          *(u32x2*)((unsigned char*)gUT + (size_t)((((uw * 4 + ct) * 2 + uvt) * 64) + 16 * g4 + ufr) * 8) = w;
        }
    } else {
      const int k = tid - 128, pk = 32 * (k >> 5) + perm_k32(k & 31);
#pragma unroll
      for (int i = 0; i < 64; ++i) gW[(size_t)i * 128 + pk] = f2bf(-X(i));
    }
  }
#undef X
  LBAR();
}

constexpr int SC_W = 0, SC_QD = 17408, SC_KDT = 34816, SC_QK = 53248, SC_O = 62464, SC_OSZ = 33792, SC_GL = SC_O + 2 * SC_OSZ;
__device__ __forceinline__ bf16x8 pack8(const f32x4 a, const f32x4 b) {
  u32x4 w; w.x = cvt_pk_bf16(a[0], a[1]); w.y = cvt_pk_bf16(a[2], a[3]); w.z = cvt_pk_bf16(b[0], b[1]); w.w = cvt_pk_bf16(b[2], b[3]);
  return __builtin_bit_cast(bf16x8, w);
}
#define SC_BAR() do { asm volatile("s_waitcnt lgkmcnt(0)" ::: "memory"); __builtin_amdgcn_s_barrier(); asm volatile("" ::: "memory"); } while (0)
__device__ __forceinline__ void scan_bh(const KArgs& a, LAS unsigned char* lds, int bh) {
  const int tid = threadIdx.x, lane = fresh_lane(), wave = __builtin_amdgcn_readfirstlane(tid >> 6), fr = lane & 15, g = lane >> 4;
  const int b = bh >> 3, h = bh & 7;
  bf16_t* P = (bf16_t*)(a.ws + WS_P);
  const float* GL = (const float*)(a.ws + WS_GL);
  const float* dnw = a.in[11];
  LAS float* gls = (LAS float*)(lds + SC_GL);
  LAS float* dnl = (LAS float*)(lds + SC_GL + 256);
  const bool cmp = wave < 4;
  const int ctid = tid & 255;
  f32x4 accS[8][2];
#pragma unroll
  for (int kt = 0; kt < 8; ++kt) { accS[kt][0] = (f32x4){0.f, 0.f, 0.f, 0.f}; accS[kt][1] = (f32x4){0.f, 0.f, 0.f, 0.f}; }
  u32x2 ut[4][2];
  u32x4 stA[14], stB[14]; u32x4 dzr[4];
  const bf16_t* dzbase = P + ((size_t)b * LPAD + (ctid >> 2)) * NPROJ + 6144 + h * 128 + 32 * (ctid & 3);
#define SC_ITEM(n) (a.ws + WS_PREP + (size_t)(bh * NCH + (n)) * PREP_ITEM)
#define SC_LOADU(n) do { const unsigned char* ib_ = SC_ITEM(n); _Pragma("unroll") for (int ct_ = 0; ct_ < 4; ++ct_) _Pragma("unroll") for (int vt_ = 0; vt_ < 2; ++vt_) \
    ut[ct_][vt_] = *(const u32x2*)(ib_ + 49152 + (size_t)((((wave * 4 + ct_) * 2 + vt_) * 64) + lane) * 8); } while (0)
#define SC_LOADT(st, n) do { const unsigned char* ib_ = SC_ITEM(n); _Pragma("unroll") for (int i_ = 0; i_ < 4; ++i_) { \
    st[i_] = *(const u32x4*)(ib_ + (size_t)(ctid + 256 * i_) * 16); st[4 + i_] = *(const u32x4*)(ib_ + 16384 + (size_t)(ctid + 256 * i_) * 16); st[8 + i_] = *(const u32x4*)(ib_ + 32768 + (size_t)(ctid + 256 * i_) * 16); } \
    st[12] = *(const u32x4*)(ib_ + 65536 + (size_t)ctid * 16); st[13] = *(const u32x4*)(ib_ + 65536 + (size_t)(ctid + 256) * 16); } while (0)
#define SC_LOADDZ(n) do { _Pragma("unroll") for (int i_ = 0; i_ < 4; ++i_) dzr[i_] = *(const u32x4*)(dzbase + (size_t)(n) * 64 * NPROJ + 8 * i_); } while (0)
#define SC_STORET(st) do { _Pragma("unroll") for (int i_ = 0; i_ < 4; ++i_) { const int q_ = ctid + 256 * i_; \
    *(LAS u32x4*)(lds + SC_W + (q_ >> 4) * 272 + (q_ & 15) * 16) = st[i_]; *(LAS u32x4*)(lds + SC_QD + (q_ >> 4) * 272 + (q_ & 15) * 16) = st[4 + i_]; \
    *(LAS u32x4*)(lds + SC_KDT + (q_ >> 3) * 144 + (q_ & 7) * 16) = st[8 + i_]; } \
    *(LAS u32x4*)(lds + SC_QK + (ctid >> 3) * 144 + (ctid & 7) * 16) = st[12]; *(LAS u32x4*)(lds + SC_QK + ((ctid + 256) >> 3) * 144 + (ctid & 7) * 16) = st[13]; } while (0)
#define SC_NORM(n, ZQ) do { const int c_ = ctid >> 2, sg_ = ctid & 3; const LAS float* ob_ = (const LAS float*)(lds + SC_O + ((n) & 1) * SC_OSZ) + c_ * 132 + 32 * sg_; \
    float o_[32]; float ss_ = 0.f; \
    _Pragma("unroll") for (int q_ = 0; q_ < 8; ++q_) { const f32x4 v_ = *(const LAS f32x4*)(ob_ + 4 * q_); o_[4 * q_] = v_[0]; o_[4 * q_ + 1] = v_[1]; o_[4 * q_ + 2] = v_[2]; o_[4 * q_ + 3] = v_[3]; } \
    _Pragma("unroll") for (int e_ = 0; e_ < 32; ++e_) ss_ += o_[e_] * o_[e_]; \
    ss_ += __shfl_xor(ss_, 1); ss_ += __shfl_xor(ss_, 2); \
    const float rstd_ = rsqrtf(ss_ * (1.f / 128.f) + 1e-6f); \
    bf16_t* dst_ = P + ((size_t)b * LPAD + (size_t)(n) * 64 + c_) * NPROJ + 1024 + h * 128 + 32 * sg_; \
    _Pragma("unroll") for (int i_ = 0; i_ < 4; ++i_) { float r_[8]; \
      _Pragma("unroll") for (int e_ = 0; e_ < 4; ++e_) { const float z0_ = bflo(ZQ[i_][e_]), z1_ = bfhi(ZQ[i_][e_]); \
        r_[2 * e_] = o_[8 * i_ + 2 * e_] * rstd_ * dnl[32 * sg_ + 8 * i_ + 2 * e_] * siluf(z0_); r_[2 * e_ + 1] = o_[8 * i_ + 2 * e_ + 1] * rstd_ * dnl[32 * sg_ + 8 * i_ + 2 * e_ + 1] * siluf(z1_); } \
      u32x4 w_; w_.x = cvt_pk_bf16(r_[0], r_[1]); w_.y = cvt_pk_bf16(r_[2], r_[3]); w_.z = cvt_pk_bf16(r_[4], r_[5]); w_.w = cvt_pk_bf16(r_[6], r_[7]); \
      *(u32x4*)(dst_ + 8 * i_) = w_; } } while (0)
  if (cmp) {
    SC_LOADU(0);
    SC_BAR();
    if (tid < NCH) gls[tid] = GL[bh * NCH + tid];
    SC_BAR();
    for (int n = 0; n < NCH; ++n) {
      const float gl = gls[n];
      f32x4 accV[4][2];
#pragma unroll
      for (int ct = 0; ct < 4; ++ct)
#pragma unroll
        for (int vt = 0; vt < 2; ++vt) accV[ct][vt] = (f32x4){bflo(ut[ct][vt].x), bfhi(ut[ct][vt].x), bflo(ut[ct][vt].y), bfhi(ut[ct][vt].y)};
      if (n + 1 < NCH) SC_LOADU(n + 1);
      bf16x8 Sf[4][2];
#pragma unroll
      for (int ks = 0; ks < 4; ++ks) { Sf[ks][0] = pack8(accS[2 * ks][0], accS[2 * ks + 1][0]); Sf[ks][1] = pack8(accS[2 * ks][1], accS[2 * ks + 1][1]); }
#define SC_FW(ct, ks) (*(const LAS bf16x8*)(lds + SC_W + (16 * (ct) + fr) * 272 + (32 * (ks) + 8 * g) * 2))
#define SC_FQ(ct, ks) (*(const LAS bf16x8*)(lds + SC_QD + (16 * (ct) + fr) * 272 + (32 * (ks) + 8 * g) * 2))
#define SC_FK(ct, ks) (*(const LAS bf16x8*)(lds + SC_QK + (16 * (ct) + fr) * 144 + (32 * (ks) + 8 * g) * 2))
#define SC_FD(kt, ks) (*(const LAS bf16x8*)(lds + SC_KDT + (16 * (kt) + fr) * 144 + (32 * (ks) + 8 * g) * 2))
      bf16x8 fa[8], fb[8];
      LAS float* ob = (LAS float*)(lds + SC_O + (n & 1) * SC_OSZ);
#pragma unroll
      for (int ks = 0; ks < 4; ++ks) { fa[ks] = SC_FW(0, ks); fa[4 + ks] = SC_FW(1, ks); }
#pragma unroll
      for (int ks = 0; ks < 4; ++ks) { fb[ks] = SC_FW(2, ks); fb[4 + ks] = SC_FW(3, ks); }
      __builtin_amdgcn_sched_barrier(0);
#pragma unroll
      for (int ks = 0; ks < 4; ++ks)
#pragma unroll
        for (int vt = 0; vt < 2; ++vt) {
          accV[0][vt] = __builtin_amdgcn_mfma_f32_16x16x32_bf16(fa[ks], Sf[ks][vt], accV[0][vt], 0, 0, 0);
          accV[1][vt] = __builtin_amdgcn_mfma_f32_16x16x32_bf16(fa[4 + ks], Sf[ks][vt], accV[1][vt], 0, 0, 0);
        }
      __builtin_amdgcn_sched_barrier(0);
#pragma unroll
      for (int ks = 0; ks < 4; ++ks) { fa[ks] = SC_FQ(0, ks); fa[4 + ks] = SC_FQ(1, ks); }
      __builtin_amdgcn_sched_barrier(0);
#pragma unroll
      for (int ks = 0; ks < 4; ++ks)
#pragma unroll
        for (int vt = 0; vt < 2; ++vt) {
          accV[2][vt] = __builtin_amdgcn_mfma_f32_16x16x32_bf16(fb[ks], Sf[ks][vt], accV[2][vt], 0, 0, 0);
          accV[3][vt] = __builtin_amdgcn_mfma_f32_16x16x32_bf16(fb[4 + ks], Sf[ks][vt], accV[3][vt], 0, 0, 0);
        }
      __builtin_amdgcn_sched_barrier(0);
      f32x4 ao[2][2];
      bf16x8 Vf[2][2];
      fb[0] = SC_FK(0, 0); fb[1] = SC_FK(0, 1); fb[2] = SC_FK(1, 0); fb[3] = SC_FK(1, 1);
      __builtin_amdgcn_sched_barrier(0);
#pragma unroll
      for (int c1 = 0; c1 < 2; ++c1) { ao[c1][0] = (f32x4){0.f, 0.f, 0.f, 0.f}; ao[c1][1] = (f32x4){0.f, 0.f, 0.f, 0.f}; }
#pragma unroll
      for (int ks = 0; ks < 4; ++ks)
#pragma unroll
        for (int vt = 0; vt < 2; ++vt) {
          ao[0][vt] = __builtin_amdgcn_mfma_f32_16x16x32_bf16(fa[ks], Sf[ks][vt], ao[0][vt], 0, 0, 0);
          ao[1][vt] = __builtin_amdgcn_mfma_f32_16x16x32_bf16(fa[4 + ks], Sf[ks][vt], ao[1][vt], 0, 0, 0);
        }
#pragma unroll
      for (int vt = 0; vt < 2; ++vt) { Vf[0][vt] = pack8(accV[0][vt], accV[1][vt]); Vf[1][vt] = pack8(accV[2][vt], accV[3][vt]); }
      __builtin_amdgcn_sched_barrier(0);
#pragma unroll
      for (int ks = 0; ks < 4; ++ks) { fa[ks] = SC_FQ(2, ks); fa[4 + ks] = SC_FQ(3, ks); }
      __builtin_amdgcn_sched_barrier(0);
#pragma unroll
      for (int ks = 0; ks < 2; ++ks)
#pragma unroll
        for (int vt = 0; vt < 2; ++vt) {
          ao[0][vt] = __builtin_amdgcn_mfma_f32_16x16x32_bf16(fb[ks], Vf[ks][vt], ao[0][vt], 0, 0, 0);
          ao[1][vt] = __builtin_amdgcn_mfma_f32_16x16x32_bf16(fb[2 + ks], Vf[ks][vt], ao[1][vt], 0, 0, 0);
        }
      __builtin_amdgcn_sched_barrier(0);
      fb[4] = SC_FK(2, 0); fb[5] = SC_FK(2, 1); fb[6] = SC_FK(3, 0); fb[7] = SC_FK(3, 1);
#pragma unroll
      for (int c1 = 0; c1 < 2; ++c1)
#pragma unroll
        for (int vt = 0; vt < 2; ++vt)
#pragma unroll
          for (int rg = 0; rg < 4; ++rg) ob[(16 * c1 + 4 * g + rg) * 132 + 32 * wave + 16 * vt + fr] = ao[c1][vt][rg];
      __builtin_amdgcn_sched_barrier(0);
#pragma unroll
      for (int c1 = 0; c1 < 2; ++c1) { ao[c1][0] = (f32x4){0.f, 0.f, 0.f, 0.f}; ao[c1][1] = (f32x4){0.f, 0.f, 0.f, 0.f}; }
#pragma unroll
      for (int ks = 0; ks < 4; ++ks)
#pragma unroll
        for (int vt = 0; vt < 2; ++vt) {
          ao[0][vt] = __builtin_amdgcn_mfma_f32_16x16x32_bf16(fa[ks], Sf[ks][vt], ao[0][vt], 0, 0, 0);
          ao[1][vt] = __builtin_amdgcn_mfma_f32_16x16x32_bf16(fa[4 + ks], Sf[ks][vt], ao[1][vt], 0, 0, 0);
        }
      __builtin_amdgcn_sched_barrier(0);
#pragma unroll
      for (int k4 = 0; k4 < 4; ++k4) { fa[2 * k4] = SC_FD(k4, 0); fa[2 * k4 + 1] = SC_FD(k4, 1); }
      __builtin_amdgcn_sched_barrier(0);
#pragma unroll
      for (int ks = 0; ks < 2; ++ks)
#pragma unroll
        for (int vt = 0; vt < 2; ++vt) {
          ao[0][vt] = __builtin_amdgcn_mfma_f32_16x16x32_bf16(fb[4 + ks], Vf[ks][vt], ao[0][vt], 0, 0, 0);
          ao[1][vt] = __builtin_amdgcn_mfma_f32_16x16x32_bf16(fb[6 + ks], Vf[ks][vt], ao[1][vt], 0, 0, 0);
        }
      __builtin_amdgcn_sched_barrier(0);
#pragma unroll
      for (int k4 = 0; k4 < 4; ++k4) { fb[2 * k4] = SC_FD(4 + k4, 0); fb[2 * k4 + 1] = SC_FD(4 + k4, 1); }
#pragma unroll
      for (int c1 = 0; c1 < 2; ++c1)
#pragma unroll
        for (int vt = 0; vt < 2; ++vt)
#pragma unroll
          for (int rg = 0; rg < 4; ++rg) ob[(32 + 16 * c1 + 4 * g + rg) * 132 + 32 * wave + 16 * vt + fr] = ao[c1][vt][rg];
#pragma unroll
      for (int kt = 0; kt < 8; ++kt) { accS[kt][0] = accS[kt][0] * gl; accS[kt][1] = accS[kt][1] * gl; }
      __builtin_amdgcn_sched_barrier(0);
#pragma unroll
      for (int ks = 0; ks < 2; ++ks)
#pragma unroll
        for (int k4 = 0; k4 < 4; ++k4)
#pragma unroll
          for (int vt = 0; vt < 2; ++vt) accS[k4][vt] = __builtin_amdgcn_mfma_f32_16x16x32_bf16(fa[2 * k4 + ks], Vf[ks][vt], accS[k4][vt], 0, 0, 0);
      __builtin_amdgcn_sched_barrier(0);
#pragma unroll
      for (int ks = 0; ks < 2; ++ks)
#pragma unroll
        for (int k4 = 0; k4 < 4; ++k4)
#pragma unroll
          for (int vt = 0; vt < 2; ++vt) accS[4 + k4][vt] = __builtin_amdgcn_mfma_f32_16x16x32_bf16(fb[2 * k4 + ks], Vf[ks][vt], accS[4 + k4][vt], 0, 0, 0);
#undef SC_FW
#undef SC_FQ
#undef SC_FK
#undef SC_FD
      SC_BAR();
      SC_BAR();
    }
    SC_BAR();
  } else {
    SC_LOADT(stA, 0);
    SC_BAR();
    if (ctid < 128) dnl[ctid] = dnw[ctid];
    SC_STORET(stA);
    SC_LOADT(stB, 1);
    SC_BAR();
    for (int n = 0; n < NCH; n += 2) {
      {
        u32x4 zc[4];
#pragma unroll
        for (int i = 0; i < 4; ++i) zc[i] = dzr[i];
        SC_LOADDZ(n);
        if (n + 2 == NCH - 1) {
          unsigned* fl = (unsigned*)(a.ws + WS_CNT + 2048) + 16 * bh; unsigned sp = 0;
          while (__hip_atomic_load(fl, __ATOMIC_RELAXED, __HIP_MEMORY_SCOPE_AGENT) == 0u) { __builtin_amdgcn_s_sleep(2); if (++sp > (1u << 22)) break; }
          __builtin_amdgcn_fence(__ATOMIC_ACQUIRE, "agent");
          asm volatile("s_waitcnt vmcnt(0)" ::: "memory");
          if (ctid == 0) gls[NCH - 1] = __hip_atomic_load((const float*)(a.ws + WS_GL + 65536) + 32 * bh, __ATOMIC_RELAXED, __HIP_MEMORY_SCOPE_AGENT);
        }
        if (n + 2 < NCH) SC_LOADT(stA, n + 2);
        if (n >= 1) SC_NORM(n - 1, zc);
        SC_BAR();
        if (n + 1 < NCH) SC_STORET(stB);
        SC_BAR();
      }
      if (n + 1 < NCH) {
        u32x4 zc[4];
#pragma unroll
        for (int i = 0; i < 4; ++i) zc[i] = dzr[i];
        SC_LOADDZ(n + 1);
        if (n + 3 < NCH) SC_LOADT(stB, n + 3);
        SC_NORM(n, zc);
        SC_BAR();
        if (n + 2 < NCH) SC_STORET(stA);
        SC_BAR();
      }
    }
    SC_NORM(NCH - 1, dzr);
    SC_BAR();
  }
#undef SC_ITEM
#undef SC_LOADU
#undef SC_LOADT
#undef SC_LOADDZ
#undef SC_STORET
#undef SC_NORM
#undef SC_BAR
  __syncthreads();
}

constexpr int AT_K1 = 0, AT_K2 = 9216, AT_V = 18432, AT_BUF = 34816, AT_O = 2 * AT_BUF;
__device__ __forceinline__ unsigned voff_b(unsigned row, unsigned ch) { return 256u * row + 16u * (ch ^ (((row & 3) << 2) | ((row >> 2) & 3))); }
__device__ __forceinline__ s16x4 tr_read(LAS unsigned char* p) { return __builtin_amdgcn_ds_read_tr16_b64_v4i16((LAS s16x4*)p); }
__device__ __forceinline__ float xsw16_max(float x) { auto r = __builtin_amdgcn_permlane16_swap(__float_as_uint(x), __float_as_uint(x), false, false); return fmaxf(__uint_as_float(r[0]), __uint_as_float(r[1])); }
__device__ __forceinline__ float xsw32_max(float x) { auto r = __builtin_amdgcn_permlane32_swap(__float_as_uint(x), __float_as_uint(x), false, false); return fmaxf(__uint_as_float(r[0]), __uint_as_float(r[1])); }
__device__ __forceinline__ float xsw16_sum(float x) { auto r = __builtin_amdgcn_permlane16_swap(__float_as_uint(x), __float_as_uint(x), false, false); return __uint_as_float(r[0]) + __uint_as_float(r[1]); }
__device__ __forceinline__ float xsw32_sum(float x) { auto r = __builtin_amdgcn_permlane32_swap(__float_as_uint(x), __float_as_uint(x), false, false); return __uint_as_float(r[0]) + __uint_as_float(r[1]); }
__device__ __forceinline__ void attn_item(const KArgs& a, LAS unsigned char* lds, int bh, int p, float lam) {
  const int tid = threadIdx.x, lane = fresh_lane(), wave = __builtin_amdgcn_readfirstlane(tid >> 6), fr = lane & 15, g = lane >> 4;
  const int b = bh >> 3, h = bh & 7, comp = wave >> 2, wq = wave & 3;
  const int cmine = 2 * p + (wq >> 1);
  const bool act = cmine < NCH;
  const int clast = (2 * p + 1 < NCH) ? 2 * p + 1 : NCH - 1;
  const bf16_t* QR = (const bf16_t*)(a.ws + WS_QR); const bf16_t* KR = (const bf16_t*)(a.ws + WS_KR);
  bf16_t* P = (bf16_t*)(a.ws + WS_P);
  const size_t rb = (size_t)b * LPAD;
  const size_t qrow0 = rb + (size_t)128 * p + 32 * wq + fr;
  bf16x8 Qf[2][2];
#pragma unroll
  for (int qt = 0; qt < 2; ++qt)
#pragma unroll
    for (int ks = 0; ks < 2; ++ks) Qf[qt][ks] = act ? *(const bf16x8*)(QR + (qrow0 + 16 * qt) * 1024 + h * 128 + comp * 64 + 32 * ks + 8 * g) : (bf16x8){0, 0, 0, 0, 0, 0, 0, 0};
  f32x4 accO[2][8];
#pragma unroll
  for (int qt = 0; qt < 2; ++qt)
#pragma unroll
    for (int et = 0; et < 8; ++et) accO[qt][et] = (f32x4){0.f, 0.f, 0.f, 0.f};
  float m[2] = {-INFINITY, -INFINITY}, lsum[2] = {0.f, 0.f};
  unsigned vaddr[8];
  { const unsigned q4 = (unsigned)fr >> 2, p4 = (unsigned)fr & 3, row0 = 4u * g + q4;
#pragma unroll
    for (int et = 0; et < 8; ++et) vaddr[et] = AT_V + voff_b(row0, 2u * et + (p4 >> 1)) + 8u * (p4 & 1); }
  u32x4 sk1, sk2, sv0, sv1;
  const int krow = tid >> 3, kch = tid & 7;
  const int vrow0 = tid >> 4, vch = tid & 15;
  const bf16_t* kp = KR + (rb + krow) * 1024 + h * 128 + kch * 8;
  const bf16_t* vp = P + (rb + vrow0) * NPROJ + 2048 + h * 128 + vch * 8;
#define AT_LOAD(kt) do { sk1 = *(const u32x4*)kp; sk2 = *(const u32x4*)(kp + 64); sv0 = *(const u32x4*)vp; sv1 = *(const u32x4*)(vp + (size_t)32 * NPROJ); \
    kp += 64 * 1024; vp += (size_t)64 * NPROJ; } while (0)
#define AT_STORE(bf) do { LAS unsigned char* l_ = lds + (bf) * AT_BUF; *(LAS u32x4*)(l_ + AT_K1 + krow * 144 + kch * 16) = sk1; *(LAS u32x4*)(l_ + AT_K2 + krow * 144 + kch * 16) = sk2; \
    *(LAS u32x4*)(l_ + AT_V + voff_b(vrow0, vch)) = sv0; *(LAS u32x4*)(l_ + AT_V + voff_b(vrow0 + 32, vch)) = sv1; } while (0)
  AT_LOAD(0);
  __syncthreads();
  AT_STORE(0);
  __syncthreads();
  for (int kt = 0; kt <= clast; ++kt) {
    LAS unsigned char* lb = lds + (kt & 1) * AT_BUF;
    LAS unsigned char* kbase = lb + (comp ? AT_K2 : AT_K1);
    if (kt < clast) AT_LOAD(kt + 1);
    if (act && kt <= cmine) {
      bf16x8 Pf[2][2];
      {
        f32x4 s[2][4];
        bf16x8 kf[4][2];
#pragma unroll
        for (int nt = 0; nt < 4; ++nt)
#pragma unroll
          for (int ks = 0; ks < 2; ++ks) kf[nt][ks] = *(const LAS bf16x8*)(kbase + (16 * nt + fr) * 144 + (32 * ks + 8 * g) * 2);
        __builtin_amdgcn_sched_barrier(0);
#pragma unroll
        for (int nt = 0; nt < 4; ++nt)
#pragma unroll
          for (int qt = 0; qt < 2; ++qt) s[qt][nt] = (f32x4){0.f, 0.f, 0.f, 0.f};
        __builtin_amdgcn_s_setprio(1);
#pragma unroll
        for (int ks = 0; ks < 2; ++ks)
#pragma unroll
          for (int nt = 0; nt < 4; ++nt)
#pragma unroll
            for (int qt = 0; qt < 2; ++qt) s[qt][nt] = __builtin_amdgcn_mfma_f32_16x16x32_bf16(kf[nt][ks], Qf[qt][ks], s[qt][nt], 0, 0, 0);
        __builtin_amdgcn_s_setprio(0);
        if (kt == 0) {
#pragma unroll
          for (int qt = 0; qt < 2; ++qt)
#pragma unroll
            for (int nt = 0; nt < 3; ++nt) s[qt][nt] = (f32x4){-INFINITY, -INFINITY, -INFINITY, -INFINITY};
        }
#pragma unroll
        for (int qt = 0; qt < 2; ++qt) {
          float mx = -INFINITY;
#pragma unroll
          for (int nt = 0; nt < 4; ++nt)
#pragma unroll
            for (int rg = 0; rg < 4; ++rg) mx = fmaxf(mx, s[qt][nt][rg]);
          mx = xsw16_max(mx); mx = xsw32_max(mx);
          const float mn = fmaxf(m[qt], mx);
          const float al = __builtin_amdgcn_exp2f(m[qt] - mn);
          const f32x4 mn4 = {mn, mn, mn, mn};
          f32x4 rs4 = {0.f, 0.f, 0.f, 0.f};
#pragma unroll
          for (int nt = 0; nt < 4; ++nt) { const f32x4 d = s[qt][nt] - mn4; f32x4 pv;
            pv[0] = __builtin_amdgcn_exp2f(d[0]); pv[1] = __builtin_amdgcn_exp2f(d[1]); pv[2] = __builtin_amdgcn_exp2f(d[2]); pv[3] = __builtin_amdgcn_exp2f(d[3]);
            s[qt][nt] = pv; rs4 = rs4 + pv; }
          float rs = (rs4[0] + rs4[1]) + (rs4[2] + rs4[3]);
          rs = xsw16_sum(rs); rs = xsw32_sum(rs);
          lsum[qt] = lsum[qt] * al + rs; m[qt] = mn;
#pragma unroll
          for (int et = 0; et < 8; ++et) accO[qt][et] = accO[qt][et] * al;
          Pf[qt][0] = pack8(s[qt][0], s[qt][1]); Pf[qt][1] = pack8(s[qt][2], s[qt][3]);
        }
      }
      {
        s16x4 va[2][8], vb[2][8];
#define AT_VLOAD(ks) do { _Pragma("unroll") for (int et_ = 0; et_ < 8; ++et_) { \
          va[ks][et_] = tr_read(lb + vaddr[et_] + (ks) * 8192); vb[ks][et_] = tr_read(lb + vaddr[et_] + (ks) * 8192 + 4096); } } while (0)
        AT_VLOAD(0);
        AT_VLOAD(1);
        __builtin_amdgcn_sched_barrier(0);
        __builtin_amdgcn_s_setprio(1);
#pragma unroll
        for (int ks = 0; ks < 2; ++ks)
#pragma unroll
          for (int et = 0; et < 8; ++et) {
            bf16x8 vf; vf[0] = va[ks][et][0]; vf[1] = va[ks][et][1]; vf[2] = va[ks][et][2]; vf[3] = va[ks][et][3]; vf[4] = vb[ks][et][0]; vf[5] = vb[ks][et][1]; vf[6] = vb[ks][et][2]; vf[7] = vb[ks][et][3];
            accO[0][et] = __builtin_amdgcn_mfma_f32_16x16x32_bf16(vf, Pf[0][ks], accO[0][et], 0, 0, 0);
            accO[1][et] = __builtin_amdgcn_mfma_f32_16x16x32_bf16(vf, Pf[1][ks], accO[1][et], 0, 0, 0);
          }
        __builtin_amdgcn_s_setprio(0);
#undef AT_VLOAD
      }
    }
    if (kt < clast) AT_STORE((kt + 1) & 1);
    __syncthreads();
  }
#pragma unroll
  for (int qt = 0; qt < 2; ++qt) {
    const float inv = act ? 1.f / lsum[qt] : 0.f;
#pragma unroll
    for (int et = 0; et < 8; ++et) accO[qt][et] = accO[qt][et] * inv;
  }
  if (comp == 1) {
#pragma unroll
    for (int qt = 0; qt < 2; ++qt) { LAS float* ob = (LAS float*)(lds + AT_O) + (wq * 32 + 16 * qt + fr) * 132;
#pragma unroll
      for (int et = 0; et < 8; ++et) *(LAS f32x4*)(ob + 16 * et + 4 * g) = accO[qt][et]; }
  }
  __syncthreads();
  if (comp == 0 && act) {
    const float* nw = a.in[10];
#pragma unroll
    for (int qt = 0; qt < 2; ++qt) {
      const LAS float* ob = (const LAS float*)(lds + AT_O) + (wq * 32 + 16 * qt + fr) * 132;
      float ss = 0.f;
#pragma unroll
      for (int et = 0; et < 8; ++et) { const f32x4 o2 = *(const LAS f32x4*)(ob + 16 * et + 4 * g); accO[qt][et] = accO[qt][et] - o2 * lam;
        ss += accO[qt][et][0] * accO[qt][et][0] + accO[qt][et][1] * accO[qt][et][1] + accO[qt][et][2] * accO[qt][et][2] + accO[qt][et][3] * accO[qt][et][3]; }
      ss = xsw16_sum(ss); ss = xsw32_sum(ss);
      const float rstd = rsqrtf(ss * (1.f / 128.f) + 1e-6f) * (1.f - LAM_INIT);
#pragma unroll
      for (int et = 0; et < 8; ++et) { const f32x4 w4 = *(const f32x4*)(nw + 16 * et + 4 * g);
        u32x2 w; w.x = cvt_pk_bf16(accO[qt][et][0] * rstd * w4[0], accO[qt][et][1] * rstd * w4[1]); w.y = cvt_pk_bf16(accO[qt][et][2] * rstd * w4[2], accO[qt][et][3] * rstd * w4[3]);
        *(u32x2*)(P + (qrow0 + 16 * qt) * NPROJ + h * 128 + 16 * et + 4 * g) = w; }
    }
  }
  __syncthreads();
#undef AT_LOAD
#undef AT_STORE
}

__device__ __forceinline__ void outproj_mini(const KArgs& a, int mu) {
  const int tid = threadIdx.x, ks = tid & 7, c8 = (tid >> 3) & 7, r8 = tid >> 6, c = 8 * mu + c8;
  const int b = r8 >> 1, t = 14 + (r8 & 1);
  const size_t row = (size_t)b * LPAD + FPAD + t;
  const bf16_t* arow = (const bf16_t*)(a.ws + WS_P) + row * NPROJ + 8 * ks;
  const bf16_t* wrow = (const bf16_t*)a.out + (size_t)c * DM + 8 * ks;
  float acc = 0.f;
#pragma unroll 8
  for (int k = 0; k < DM; k += 64) {
    const u32x4 av = *(const u32x4*)(arow + k), wv = *(const u32x4*)(wrow + k);
#pragma unroll
    for (int e = 0; e < 4; ++e) acc += bflo(av[e]) * bflo(wv[e]) + bfhi(av[e]) * bfhi(wv[e]);
  }
  acc += __shfl_xor(acc, 1); acc += __shfl_xor(acc, 2); acc += __shfl_xor(acc, 4);
  if (ks == 0) ((float*)(a.ws + WS_PRE1))[row * DM + c] = acc + ALPHA * a.in[1][(size_t)t * DM + c];
}

__device__ __forceinline__ void ln1_rows(const KArgs& a, int gw, int ngw, int lane) {
  const float* PRE = (const float*)(a.ws + WS_PRE1); bf16_t* H1B = (bf16_t*)(a.ws + WS_H1B);
  const float* gam = a.in[13]; const float* bet = a.in[14];
  f32x4 v[8];
  int r = gw;
#define LN1_T(rr) (((rr) % LPAD) - FPAD)
#define LN1_LOAD(dst, rr) do { const f32x4* xr_ = (const f32x4*)(PRE + (size_t)(rr) * DM) + lane; _Pragma("unroll") for (int i_ = 0; i_ < 8; ++i_) dst[i_] = xr_[64 * i_]; } while (0)
  if (r < R && LN1_T(r) >= 14) LN1_LOAD(v, r);
  while (r < R) {
    const int rn = r + ngw;
    const int b = r / LPAD, t = r - b * LPAD - FPAD;
    f32x4 w[8];
    if (rn < R && LN1_T(rn) >= 14) LN1_LOAD(w, rn);
    u32x2* orow = (u32x2*)(H1B + (size_t)r * DM);
    if (t < 14) {
#pragma unroll
      for (int i = 0; i < 8; ++i) orow[lane + 64 * i] = (u32x2){0u, 0u};
    } else {
      float s = 0.f;
#pragma unroll
      for (int i = 0; i < 8; ++i) s += (v[i][0] + v[i][1]) + (v[i][2] + v[i][3]);
      const float mean = wave_sum(s) * (1.f / DM); float s2 = 0.f;
#pragma unroll
      for (int i = 0; i < 8; ++i) { v[i] = v[i] - mean; s2 += (v[i][0] * v[i][0] + v[i][1] * v[i][1]) + (v[i][2] * v[i][2] + v[i][3] * v[i][3]); }
      const float rstd = rsqrtf(wave_sum(s2) * (1.f / DM) + 1e-5f);
      float* of = t >= NMETA ? a.out + ((size_t)b * SEQ + (t - NMETA)) * DM : nullptr;
#pragma unroll
      for (int i = 0; i < 8; ++i) {
        const f32x4 gg = *((const f32x4*)gam + lane + 64 * i), bb = *((const f32x4*)bet + lane + 64 * i);
        const f32x4 y = v[i] * rstd * gg + bb;
        orow[lane + 64 * i] = (u32x2){cvt_pk_bf16(y[0], y[1]), cvt_pk_bf16(y[2], y[3])};
        if (of) *((f32x4*)of + lane + 64 * i) = y;
      }
    }
#pragma unroll
    for (int i = 0; i < 8; ++i) v[i] = w[i];
    r = rn;
  }
#undef LN1_T
#undef LN1_LOAD
}
__device__ __forceinline__ void ln1_side_rows(const KArgs& a, int gw, int lane) {
  if (gw >= 8) return;
  const float* PRE = (const float*)(a.ws + WS_PRE1); bf16_t* H1B = (bf16_t*)(a.ws + WS_H1B);
  const float* gam = a.in[13]; const float* bet = a.in[14];
  const int r = (gw >> 1) * LPAD + FPAD + 14 + (gw & 1);
  const f32x4* xr = (const f32x4*)(PRE + (size_t)r * DM) + lane;
  u32x2* orow = (u32x2*)(H1B + (size_t)r * DM);
  f32x4 v[8]; float s = 0.f;
#pragma unroll
  for (int i = 0; i < 8; ++i) { v[i] = xr[64 * i]; s += (v[i][0] + v[i][1]) + (v[i][2] + v[i][3]); }
  const float mean = wave_sum(s) * (1.f / DM); float s2 = 0.f;
#pragma unroll
  for (int i = 0; i < 8; ++i) { v[i] = v[i] - mean; s2 += (v[i][0] * v[i][0] + v[i][1] * v[i][1]) + (v[i][2] * v[i][2] + v[i][3] * v[i][3]); }
  const float rstd = rsqrtf(wave_sum(s2) * (1.f / DM) + 1e-5f);
#pragma unroll
  for (int i = 0; i < 8; ++i) {
    const f32x4 gg = *((const f32x4*)gam + lane + 64 * i), bb = *((const f32x4*)bet + lane + 64 * i);
    const f32x4 y = v[i] * rstd * gg + bb;
    orow[lane + 64 * i] = (u32x2){cvt_pk_bf16(y[0], y[1]), cvt_pk_bf16(y[2], y[3])};
  }
}
__device__ __forceinline__ void ln2_rows(const KArgs& a, int gw, int ngw, int lane) {
  const float* gam = a.in[20]; const float* bet = a.in[21];
  f32x4 v[8];
  int r = gw;
  if (r < NB * SEQ) { const f32x4* xr = (const f32x4*)(a.out + (size_t)r * DM) + lane;
#pragma unroll
    for (int i = 0; i < 8; ++i) v[i] = xr[64 * i]; }
  while (r < NB * SEQ) {
    const int rn = r + ngw;
    f32x4 w[8];
    if (rn < NB * SEQ) { const f32x4* xn = (const f32x4*)(a.out + (size_t)rn * DM) + lane;
#pragma unroll
      for (int i = 0; i < 8; ++i) w[i] = xn[64 * i]; }
    f32x4* xr = (f32x4*)(a.out + (size_t)r * DM) + lane;
    float s = 0.f;
#pragma unroll
    for (int i = 0; i < 8; ++i) s += (v[i][0] + v[i][1]) + (v[i][2] + v[i][3]);
    const float mean = wave_sum(s) * (1.f / DM); float s2 = 0.f;
#pragma unroll
    for (int i = 0; i < 8; ++i) { v[i] = v[i] - mean; s2 += (v[i][0] * v[i][0] + v[i][1] * v[i][1]) + (v[i][2] * v[i][2] + v[i][3] * v[i][3]); }
    const float rstd = rsqrtf(wave_sum(s2) * (1.f / DM) + 1e-5f);
#pragma unroll
    for (int i = 0; i < 8; ++i) {
      const f32x4 gg = *((const f32x4*)gam + lane + 64 * i), bb = *((const f32x4*)bet + lane + 64 * i);
      xr[64 * i] = v[i] * rstd * gg + bb;
    }
#pragma unroll
    for (int i = 0; i < 8; ++i) v[i] = w[i];
    r = rn;
  }
}

#define XB_TMO      128
#define XB_XCNT(j)  (256  + 64 * (j))
#define XB_XSUB(j)  (1280 + 64 * (j))
#define XB_XGEN(j)  (2304 + 64 * (j))
#define XB_TOP      3328
#define XB_TOPGEN   3392
#define XCD_BAR_WORDS 3456
#define XB_SPIN_CAP (1u << 18)
__device__ __forceinline__ unsigned xb_ld(unsigned* p)              { return __hip_atomic_load(p, __ATOMIC_RELAXED, __HIP_MEMORY_SCOPE_AGENT); }
__device__ __forceinline__ unsigned xb_add(unsigned* p, unsigned v) { return __hip_atomic_fetch_add(p, v, __ATOMIC_RELAXED, __HIP_MEMORY_SCOPE_AGENT); }
__device__ __forceinline__ unsigned xb_xcc_id() { return (unsigned)__builtin_amdgcn_s_getreg((3 << 11) | 20) & 0xFu; }
#define XB_SPIN(cond, bar) do { unsigned _sp = 0; while (cond) { __builtin_amdgcn_s_sleep(1); \
    if ((++_sp & 255u) == 0u) { if (xb_ld(&(bar)[XB_TMO])) break; if (_sp > XB_SPIN_CAP) { atomicAdd(&(bar)[XB_TMO], 1u); break; } } } } while (0)
struct XcdBarrier { unsigned* bar; unsigned x; volatile LAS unsigned* st; };
__device__ __forceinline__ XcdBarrier xcd_barrier_post(unsigned* bar, volatile LAS unsigned* st) {
  XcdBarrier b; b.bar = bar; b.x = xb_xcc_id(); b.st = st;
  if (threadIdx.x == 0) (void)xb_add(&bar[XB_XCNT(b.x)], 1u);
  return b;
}
__device__ __forceinline__ void xcd_barrier_complete(unsigned* bar, unsigned x, unsigned& nloc, unsigned& nx) {
  const unsigned G = gridDim.x;
  unsigned sum, cnt, mine, sp = 0u;
  for (;;) {
    sum = 0u; cnt = 0u; mine = 0u;
#pragma unroll
    for (unsigned j = 0; j < 16; ++j) { const unsigned c = xb_ld(&bar[XB_XCNT(j)]); sum += c; cnt += (c > 0u) ? 1u : 0u; mine = (j == x) ? c : mine; }
    if (sum == G) break;
    __builtin_amdgcn_s_sleep(1);
    if ((++sp & 255u) == 0u) { if (xb_ld(&bar[XB_TMO])) break; if (sp > XB_SPIN_CAP) { atomicAdd(&bar[XB_TMO], 1u); break; } }
  }
  nloc = mine > 0u ? mine : 1u; nx = cnt > 0u ? cnt : 1u;
}
__device__ __forceinline__ void xcd_barrier(const XcdBarrier& b) {
  asm volatile("s_waitcnt vmcnt(0)" ::: "memory");
  __syncthreads();
  if (threadIdx.x == 0) {
    unsigned* bar = b.bar;
    __builtin_amdgcn_s_waitcnt(0);
    unsigned nloc = b.st[0], nx = b.st[1];
    if (nloc == 0u) { xcd_barrier_complete(bar, b.x, nloc, nx); b.st[0] = nloc; b.st[1] = nx; }
    const unsigned old = xb_add(&bar[XB_XSUB(b.x)], 1u);
    const unsigned gen = old / nloc;
    if (old + 1u == (gen + 1u) * nloc) {
      __builtin_amdgcn_fence(__ATOMIC_RELEASE, "agent");
      asm volatile("s_waitcnt vmcnt(0)" ::: "memory");
      const unsigned og = xb_add(&bar[XB_TOP], 1u);
      const unsigned tg = og / nx;
      if (og + 1u == (tg + 1u) * nx) xb_add(&bar[XB_TOPGEN], 1u);
      else XB_SPIN(xb_ld(&bar[XB_TOPGEN]) == tg, bar);
      __builtin_amdgcn_fence(__ATOMIC_ACQUIRE, "agent");
      xb_add(&bar[XB_XGEN(b.x)], 1u);
      asm volatile("s_waitcnt vmcnt(0)" ::: "memory");
    } else {
      XB_SPIN(xb_ld(&bar[XB_XGEN(b.x)]) == gen, bar);
      __builtin_amdgcn_fence(__ATOMIC_ACQUIRE, "agent");
      asm volatile("s_waitcnt vmcnt(0)" ::: "memory");
    }
  }
  __syncthreads();
}

__global__ void __launch_bounds__(NTHR, 2) mega(KArgs a) {
  extern __shared__ __attribute__((aligned(16))) unsigned char lds_raw[];
  LAS unsigned char* lds = (LAS unsigned char*)lds_raw;
  const int tid = threadIdx.x, wave = __builtin_amdgcn_readfirstlane(tid >> 6);
  const int G = gridDim.x, gw = blockIdx.x * NWAVE + wave, ngw = G * NWAVE;
  const int lo = a.ph_lo, hi = a.ph_hi;
#define IN(k) (lo <= (k) && (k) < hi)
#define SEAM0() do { if (IN(0) && IN(1)) xcd_barrier(xbar); } while (0)
#define SEAM(k) do { if (IN(k) && IN((k) + 1)) xcd_barrier(xbar); } while (0)
  volatile LAS unsigned* xst = (volatile LAS unsigned*)(lds + 147200);
  XcdBarrier xbar; xbar.bar = (unsigned*)(a.ws + WS_CNT + 16384); xbar.x = 0; xbar.st = xst;
  if (hi - lo > 1) {
    if (tid < 2) xst[tid] = 0u;
    __syncthreads();
    xbar = xcd_barrier_post((unsigned*)(a.ws + WS_CNT + 16384), xst);
  }
  if (a.ph_hi > 1000) cg::this_grid().sync();
  if (IN(0)) {
    p0_rows(a, lds, gw, ngw, fresh_lane());
    transpose_all(a.in[2], DM, INCOLS, NPROJ, (bf16_t*)(a.ws + WS_WINT), lds, gw, ngw, wave, fresh_lane());
  }
  SEAM0();
  if (IN(1)) {
    pg8::Gemm g{(const bf16_t*)(a.ws + WS_H0), (const bf16_t*)(a.ws + WS_WINT), DM, DM, 0};
    pg8::StaticOrder S; S.init(R / 256, NPROJ / 256, G, (int)blockIdx.x);
    pg8::EpiBf16 E{(bf16_t*)(a.ws + WS_P), NPROJ};
    pg8::gemm_phase<pg8::EpiBf16>(lds, g, S, E);
  }
  SEAM(1);
  if (IN(2)) {
    p2_rope(a, gw, ngw, fresh_lane());
    transpose_all(a.in[12], DM, DM, DM, (bf16_t*)a.out, lds, gw, ngw, wave, fresh_lane());
    __syncthreads();
#define PREP_ITEM_OF(L) ((((L) >> 5) * NCH) + ((L) & 31))
    if (wave == 0 && (int)blockIdx.x < 1024) prep_stepA(a, lds, PREP_ITEM_OF((int)blockIdx.x), 0, fresh_lane());
    __syncthreads();
    { int slot = 0;
      for (int L = blockIdx.x; L < 1024; L += G) { prep_item(a, lds, PREP_ITEM_OF(L), slot, L + G < 1024 ? PREP_ITEM_OF(L + G) : -1); slot ^= 1; } }
  }
  SEAM(2);
  if (IN(3)) {
    LAS int* qslot = (LAS int*)(lds + 147000);
    const float p1 = a.in[6][fresh_lane()] * a.in[7][fresh_lane()], p2 = a.in[8][fresh_lane()] * a.in[9][fresh_lane()];
    const float lam = expf(wave_sum(p1)) - expf(wave_sum(p2)) + LAM_INIT;
    if (blockIdx.x < NB * 8) scan_bh(a, lds, (int)blockIdx.x);
    else if (blockIdx.x < 2 * NB * 8) {
      const int pbh = (int)blockIdx.x - NB * 8, pit = pbh * NCH + (NCH - 1);
      if (wave == 0) prep_stepA(a, lds, pit, 0, fresh_lane());
      __syncthreads();
      prep_item(a, lds, pit, 0, -1);
      asm volatile("s_waitcnt vmcnt(0)" ::: "memory");
      __syncthreads();
      if (tid == 0) {
        const float glv = ((const float*)(a.ws + WS_GL))[pit];
        __builtin_amdgcn_fence(__ATOMIC_RELEASE, "agent");
        asm volatile("s_waitcnt vmcnt(0)" ::: "memory");
        __hip_atomic_store((float*)(a.ws + WS_GL + 65536) + 32 * pbh, glv, __ATOMIC_RELAXED, __HIP_MEMORY_SCOPE_AGENT);
        asm volatile("s_waitcnt vmcnt(0)" ::: "memory");
        __hip_atomic_store((unsigned*)(a.ws + WS_CNT + 2048) + 16 * pbh, 1u, __ATOMIC_RELAXED, __HIP_MEMORY_SCOPE_AGENT);
      }
    }
    unsigned* cnt = (unsigned*)(a.ws + WS_CNT);
    for (;;) {
      __syncthreads();
      if (tid == 0) *qslot = (int)atomicAdd(cnt, 1u);
      __syncthreads();
      const int q = *qslot;
      if (q >= NB * 8 * 17) break;
      attn_item(a, lds, q & 31, 16 - (q >> 5), lam);
    }
  }
  SEAM(3);
  if (IN(4)) {
    for (int mu = blockIdx.x; mu < 256; mu += G) outproj_mini(a, mu);
    pg8::Gemm g{(const bf16_t*)(a.ws + WS_P), (const bf16_t*)a.out, NPROJ, DM, 1};
    pg8::StaticOrder S; S.init(NB * SEQ / 256, DM / 256, G, (int)blockIdx.x);
    if (G == 256 && hi - lo > 1) {
      pg8::EpiOutProjLN E{a.in[0], a.out + 0, (bf16_t*)(a.ws + WS_H1B), a.in[13], a.in[14], (unsigned long long*)(a.ws + 3 * MiB + 524288), (unsigned*)(a.ws + WS_CNT + 4096) + 32, &xbar};
      pg8::gemm_phase<pg8::EpiOutProjLN>(lds, g, S, E);
      ln1_side_rows(a, gw, fresh_lane());
    } else {
      pg8::EpiOutProj E{(float*)(a.ws + WS_PRE1), a.in[0]};
      pg8::gemm_phase<pg8::EpiOutProj>(lds, g, S, E);
    }
    transpose_all(a.in[15], DM, DFF, DFF, (bf16_t*)(a.ws + WS_WG), lds, gw, ngw, wave, fresh_lane());
    transpose_all(a.in[16], DM, DFF, DFF, (bf16_t*)(a.ws + WS_WU), lds, gw, ngw, wave, fresh_lane());
  }
  SEAM(4);
  if (!(G == 256 && hi - lo > 1)) {
    if (IN(5)) ln1_rows(a, gw, ngw, fresh_lane());
    SEAM(5);
  }
  if (IN(6)) {
    pg8::Gemm g{(const bf16_t*)(a.ws + WS_H1B), (const bf16_t*)(a.ws + WS_WG), DM, DM, 0};
    pg8::StaticOrder S; S.init(R / 256, DFF / 256, G, (int)blockIdx.x);
    pg8::EpiBf16 E{(bf16_t*)(a.ws + WS_G), DFF};
    pg8::gemm_phase<pg8::EpiBf16>(lds, g, S, E);
  }
  SEAM(6);
  if (IN(7)) {
    pg8::Gemm g{(const bf16_t*)(a.ws + WS_H1B), (const bf16_t*)(a.ws + WS_WU), DM, DM, 0};
    pg8::StaticOrder S; S.init(R / 256, DFF / 256, G, (int)blockIdx.x);
    pg8::EpiUpAct E{(bf16_t*)(a.ws + WS_ACT), (const bf16_t*)(a.ws + WS_G), a.in[17], a.in[18]};
    pg8::gemm_phase<pg8::EpiUpAct>(lds, g, S, E);
    transpose_all(a.in[19], DFF, DM, DM, (bf16_t*)(a.ws + WS_WG), lds, gw, ngw, wave, fresh_lane());
  }
  SEAM(7);
  if (IN(8)) {
    pg8::Gemm g{(const bf16_t*)(a.ws + WS_ACT), (const bf16_t*)(a.ws + WS_WG), DFF, DFF, 1};
    pg8::StaticOrder S; S.init(NB * SEQ / 256, DM / 256, G, (int)blockIdx.x);
    if (G == 256) {
      pg8::EpiDownLN E{a.out, a.in[20], a.in[21], (unsigned long long*)(a.ws + 3 * MiB), (unsigned*)(a.ws + WS_CNT + 4096)};
      pg8::gemm_phase<pg8::EpiDownLN>(lds, g, S, E);
    } else {
      pg8::EpiDown E{a.out};
      pg8::gemm_phase<pg8::EpiDown>(lds, g, S, E);
    }
  }
  if (G != 256) {
    SEAM(8);
    if (IN(9)) ln2_rows(a, gw, ngw, fresh_lane());
  }
}


#ifdef DBG_STAGE
__global__ void dbg_dump(const void* buf, size_t n, int isbf, size_t row_elems, size_t col_lo, size_t col_hi, float* out, size_t nout) {
  for (size_t i = (size_t)blockIdx.x * blockDim.x + threadIdx.x; i < nout; i += (size_t)gridDim.x * blockDim.x) {
    float flag = 0.f;
    for (size_t j = i; j < n; j += nout) {
      const size_t c = j % row_elems;
      if (c < col_lo || c >= col_hi) continue;
      const float v = isbf ? bf2f(((const bf16_t*)buf)[j]) : ((const float*)buf)[j];
      if (!(v == v) || fabsf(v) > 1e30f) flag = 1000.f;
    }
    out[i] = flag;
  }
}
#endif
extern "C" void kernel_launch(void* const* d_in, const int* in_sizes, int n_in, void* d_out, int out_size, void* d_ws, size_t ws_size, hipStream_t stream) {
  static int grid = 0;
  if (grid == 0) {
    int dev = 0, cus = 0, per_cu = 0;
    (void)hipGetDevice(&dev);
    (void)hipDeviceGetAttribute(&cus, hipDeviceAttributeMultiprocessorCount, dev);
    (void)hipFuncSetAttribute((const void*)mega, hipFuncAttributeMaxDynamicSharedMemorySize, LDS_BYTES);
    (void)hipOccupancyMaxActiveBlocksPerMultiprocessor(&per_cu, (const void*)mega, NTHR, LDS_BYTES);
    if (per_cu < 1) per_cu = 1;
    grid = cus * 1;
    if (n_in != 22 || ws_size < WS_END) { fprintf(stderr, "kernel_launch: bad sizes n_in %d ws %zu\n", n_in, ws_size); grid = -1; }
  }
  if (grid < 0) return;
  (void)hipMemsetAsync((char*)d_ws + WS_CNT, 0, 32768, stream);
  KArgs a{};
  for (int i = 0; i < 22; ++i) a.in[i] = (const float*)d_in[i];
  a.out = (float*)d_out; a.ws = (unsigned char*)d_ws; a.ph_lo = 0; a.ph_hi = 10;
#ifndef MK_SPLIT
#define MK_SPLIT 0
#endif
  hipError_t e = hipSuccess;
#if MK_SPLIT
#ifdef DBG_STAGE
  const int nph = DBG_STAGE + 1;
#else
  const int nph = 10;
#endif
  for (int ph = 0; ph < nph; ++ph) { a.ph_lo = ph; a.ph_hi = ph + 1; hipLaunchKernelGGL(mega, dim3(grid), dim3(NTHR), LDS_BYTES, stream, a); }
#ifdef DBG_STAGE
  { unsigned char* w = (unsigned char*)d_ws; float* o = (float*)d_out; const size_t no = (size_t)out_size;
    if (DBG_STAGE == 0) hipLaunchKernelGGL(dbg_dump, dim3(2048), dim3(256), 0, stream, (const void*)(w + WS_H0), (size_t)R * DM, 1, (size_t)DM, (size_t)0, (size_t)DM, o, no);
    if (DBG_STAGE == 1) hipLaunchKernelGGL(dbg_dump, dim3(2048), dim3(256), 0, stream, (const void*)(w + WS_P), (size_t)R * NPROJ, 1, (size_t)NPROJ, (size_t)0, (size_t)NPROJ, o, no);
    if (DBG_STAGE == 2) hipLaunchKernelGGL(dbg_dump, dim3(2048), dim3(256), 0, stream, (const void*)(w + WS_QR), (size_t)(WS_WOUT - WS_QR) / 2 + (size_t)DM * DM, 1, (size_t)64, (size_t)0, (size_t)64, o, no);
    if (DBG_STAGE == 3) hipLaunchKernelGGL(dbg_dump, dim3(2048), dim3(256), 0, stream, (const void*)(w + WS_P), (size_t)R * NPROJ, 1, (size_t)NPROJ, (size_t)DBG_CLO, (size_t)DBG_CHI, o, no);
    if (DBG_STAGE == 4) hipLaunchKernelGGL(dbg_dump, dim3(2048), dim3(256), 0, stream, (const void*)(w + WS_PRE1), (size_t)R * DM, 0, (size_t)DM, (size_t)0, (size_t)DM, o, no);
    if (DBG_STAGE == 5) hipLaunchKernelGGL(dbg_dump, dim3(2048), dim3(256), 0, stream, (const void*)(w + WS_H1B), (size_t)R * DM, 1, (size_t)DM, (size_t)0, (size_t)DM, o, no);
    if (DBG_STAGE == 6) hipLaunchKernelGGL(dbg_dump, dim3(2048), dim3(256), 0, stream, (const void*)(w + WS_G), (size_t)R * DFF, 1, (size_t)DFF, (size_t)0, (size_t)DFF, o, no);
    if (DBG_STAGE == 7) hipLaunchKernelGGL(dbg_dump, dim3(2048), dim3(256), 0, stream, (const void*)(w + WS_ACT), (size_t)R * DFF, 1, (size_t)DFF, (size_t)0, (size_t)DFF, o, no);
  }
#endif
  e = hipGetLastError();
#else
  void* args[] = {&a};
  e = hipLaunchCooperativeKernel((void*)mega, dim3(grid), dim3(NTHR), args, LDS_BYTES, stream);
#endif
  if (e != hipSuccess) fprintf(stderr, "cooperative launch failed: %s (grid %d)\n", hipGetErrorString(e), grid);
}
```
